# Optimizing an MI355X kernel written in HIP

```python
import jax, jax.numpy as jnp
from jax import lax
import numpy as np

D_MODEL = 1024
BATCH = 4
SEQ = 8192
DEPTH = 1

N_META = 16
D_MIX = D_MODEL
MLA_HEADS = 8
QK_NOPE_DIM = 64
QK_ROPE_DIM = 32
QK_HEAD_DIM = QK_NOPE_DIM + QK_ROPE_DIM
V_HEAD_DIM = 64
Q_LORA_RANK = 256
KV_LORA_RANK = 128
MLA_WIDTH = MLA_HEADS * V_HEAD_DIM
FOURIER_GROUPS = 4
FOURIER_WIDTH = D_MIX - MLA_WIDTH
FOURIER_GROUP_DIM = FOURIER_WIDTH // FOURIER_GROUPS
IN_WIDTH = Q_LORA_RANK + KV_LORA_RANK + QK_ROPE_DIM + FOURIER_WIDTH
D_FF = ((8 * D_MODEL // 3 + 255) // 256) * 256
ROPE_THETA = 10000.0
Q_BLOCK = 128
EPS = 1e-6

kernel_name = "hymba_mla_fnet_sandwich_encoder"


def rmsnorm(x, g):
    xf = x.astype(jnp.float32)
    y = xf * lax.rsqrt(jnp.mean(xf * xf, axis=-1, keepdims=True) + EPS)
    return (y * g.astype(jnp.float32)).astype(x.dtype)


def rope_tables(length, dim):
    pos = jnp.arange(length, dtype=jnp.float32)
    inv_freq = ROPE_THETA ** (-jnp.arange(0, dim, 2, dtype=jnp.float32) / dim)
    ang = pos[:, None] * inv_freq[None, :]
    return jnp.cos(ang), jnp.sin(ang)


def apply_rope(x, cos, sin):
    half = x.shape[-1] // 2
    x1 = x[..., :half].astype(jnp.float32)
    x2 = x[..., half:].astype(jnp.float32)
    c = cos[None, :, None, :]
    s = sin[None, :, None, :]
    out = jnp.concatenate([x1 * c - x2 * s, x2 * c + x1 * s], axis=-1)
    return out.astype(x.dtype)


def mla_mixer(cq, ckv, k_rope_raw, q_a_norm, w_q_b, kv_a_norm, w_kv_b):
    B, L, _ = cq.shape
    cos, sin = rope_tables(L, QK_ROPE_DIM)
    cq = rmsnorm(cq, q_a_norm)
    q = (cq @ w_q_b).reshape(B, L, MLA_HEADS, QK_HEAD_DIM)
    q = jnp.concatenate([q[..., :QK_NOPE_DIM], apply_rope(q[..., QK_NOPE_DIM:], cos, sin)], axis=-1)
    ckv = rmsnorm(ckv, kv_a_norm)
    kv = (ckv @ w_kv_b).reshape(B, L, MLA_HEADS, QK_NOPE_DIM + V_HEAD_DIM)
    k_nope, v = kv[..., :QK_NOPE_DIM], kv[..., QK_NOPE_DIM:]
    k_rope = apply_rope(k_rope_raw[:, :, None, :], cos, sin)
    k = jnp.concatenate([k_nope, jnp.broadcast_to(k_rope, (B, L, MLA_HEADS, QK_ROPE_DIM))], axis=-1)
    scale = 1.0 / float(np.sqrt(QK_HEAD_DIM))
    n_blk = (L + Q_BLOCK - 1) // Q_BLOCK
    Lp = n_blk * Q_BLOCK
    qp = jnp.pad(q, ((0, 0), (0, Lp - L), (0, 0), (0, 0)))
    qb = qp.reshape(B, n_blk, Q_BLOCK, MLA_HEADS, QK_HEAD_DIM).transpose(1, 0, 2, 3, 4)

    def attend(q_blk):
        s = jnp.einsum('bqhd,bkhd->bhqk', q_blk, k).astype(jnp.float32) * scale
        p = jax.nn.softmax(s, axis=-1).astype(v.dtype)
        return jnp.einsum('bhqk,bkhd->bqhd', p, v)

    o = lax.map(attend, qb)
    o = o.transpose(1, 0, 2, 3, 4).reshape(B, Lp, MLA_WIDTH)[:, :L]
    return o


def fourier_mixer(f_in, w_fourier, b_fourier):
    B, L, _ = f_in.shape
    f = f_in.reshape(B, L, FOURIER_GROUPS, FOURIER_GROUP_DIM).astype(jnp.float32)
    F = jnp.fft.fftn(f, axes=(1, 3), norm='ortho').real.astype(f_in.dtype)
    y = jnp.einsum('blgc,gcd->blgd', F, w_fourier) + b_fourier
    return y.reshape(B, L, FOURIER_WIDTH)


def setup_inputs(seed: int = 0) -> dict:
    key = jax.random.key(seed)
    ks = jax.random.split(key, 20)
    f32 = jnp.float32

    def w(k, shape, fan_in):
        return jax.random.normal(k, shape, f32) * fan_in ** -0.5

    def gain(k, shape):
        return 1.0 + 0.01 * jax.random.normal(k, shape, f32)

    return {
        "x": jax.random.normal(ks[0], (BATCH, SEQ, D_MODEL), f32),
        "meta_tokens": jax.random.normal(ks[1], (N_META, D_MODEL), f32),
        "norm_pre_mix": gain(ks[2], (DEPTH, D_MODEL)),
        "w_in": w(ks[3], (DEPTH, D_MODEL, IN_WIDTH), D_MODEL),
        "q_a_norm": gain(ks[4], (DEPTH, Q_LORA_RANK)),
        "w_q_b": w(ks[5], (DEPTH, Q_LORA_RANK, MLA_HEADS * QK_HEAD_DIM), Q_LORA_RANK),
        "kv_a_norm": gain(ks[6], (DEPTH, KV_LORA_RANK)),
        "w_kv_b": w(ks[7], (DEPTH, KV_LORA_RANK, MLA_HEADS * (QK_NOPE_DIM + V_HEAD_DIM)), KV_LORA_RANK),
        "w_fourier": w(ks[8], (DEPTH, FOURIER_GROUPS, FOURIER_GROUP_DIM, FOURIER_GROUP_DIM), FOURIER_GROUP_DIM),
        "b_fourier": 0.01 * jax.random.normal(ks[9], (DEPTH, FOURIER_GROUPS, FOURIER_GROUP_DIM), f32),
        "mix_gain_attn": gain(ks[10], (DEPTH, MLA_WIDTH)),
        "mix_gain_fourier": gain(ks[11], (DEPTH, FOURIER_WIDTH)),
        "w_o": w(ks[12], (DEPTH, D_MIX, D_MODEL), D_MIX),
        "norm_post_mix": gain(ks[13], (DEPTH, D_MODEL)),
        "norm_pre_ffn": gain(ks[14], (DEPTH, D_MODEL)),
        "w_gate": w(ks[15], (DEPTH, D_MODEL, D_FF), D_MODEL),
        "w_up": w(ks[16], (DEPTH, D_MODEL, D_FF), D_MODEL),
        "w_down": w(ks[17], (DEPTH, D_FF, D_MODEL), D_FF),
        "norm_post_ffn": gain(ks[18], (DEPTH, D_MODEL)),
    }


def reference(x, meta_tokens, norm_pre_mix, w_in, q_a_norm, w_q_b, kv_a_norm, w_kv_b,
              w_fourier, b_fourier, mix_gain_attn, mix_gain_fourier, w_o, norm_post_mix,
              norm_pre_ffn, w_gate, w_up, w_down, norm_post_ffn):
    B = x.shape[0]
    meta = jnp.broadcast_to(meta_tokens[None].astype(x.dtype), (B, N_META, D_MODEL))
    h_res = jnp.concatenate([meta, x], axis=1)
    o1 = Q_LORA_RANK
    o2 = o1 + KV_LORA_RANK
    o3 = o2 + QK_ROPE_DIM
    for i in range(DEPTH):
        h = rmsnorm(h_res, norm_pre_mix[i])
        z = h @ w_in[i]
        attn = mla_mixer(z[..., :o1], z[..., o1:o2], z[..., o2:o3],
                         q_a_norm[i], w_q_b[i], kv_a_norm[i], w_kv_b[i])
        four = fourier_mixer(z[..., o3:], w_fourier[i], b_fourier[i])
        merged = jnp.concatenate([rmsnorm(attn, mix_gain_attn[i]),
                                  rmsnorm(four, mix_gain_fourier[i])], axis=-1)
        h_res = h_res + rmsnorm(merged @ w_o[i], norm_post_mix[i])
        h = rmsnorm(h_res, norm_pre_ffn[i])
        ff = (jax.nn.silu(h @ w_gate[i]) * (h @ w_up[i])) @ w_down[i]
        h_res = h_res + rmsnorm(ff, norm_post_ffn[i])
    return h_res[:, N_META:]
```

```cpp
#include <hip/hip_runtime.h>
#include <cstdio>
#include <cstdint>

constexpr int NB = 4, SEQ = 8192, LTOK = 8208, DM = 1024, NMETA = 16;
constexpr int MX = NB * SEQ;
constexpr int MNAT = NB * LTOK;
constexpr int INW = 928, QLR = 256, KVLR = 128, ROPED = 32, NH = 8, DQK = 96, DV = 64;
constexpr int FW = 512, FGD = 128;
constexpr int DFF = 2816;
constexpr int FN1 = 108, FN2 = 76;
constexpr int KVROWS = 33024;
constexpr int META_ROW0 = 32768;
constexpr float EPS = 1e-6f;
constexpr float C2 = 0.10206207261596577f * 1.4426950408889634f;

constexpr size_t MiB = 1u << 20;
constexpr size_t WS_CTL = 0, CTL_ZERO_BYTES = 1 * MiB;
constexpr size_t WS_ROPE = 1 * MiB;
constexpr size_t WS_TW = 3 * MiB;
constexpr size_t WS_WU = 4 * MiB;
constexpr size_t WS_XN = 32 * MiB;
constexpr size_t WS_ZQ = 97 * MiB;
constexpr size_t WS_ZKV = 113 * MiB;
constexpr size_t WS_Q = 130 * MiB;
constexpr size_t WS_KB = 178 * MiB;
constexpr size_t WS_VB = 227 * MiB;
constexpr size_t WS_X0 = 260 * MiB;
constexpr size_t WS_X1 = 336 * MiB;
constexpr size_t WS_AO = 444 * MiB;
constexpr size_t WS_MRG = 130 * MiB;
constexpr size_t WS_ACT = 260 * MiB;
constexpr size_t WS_Z = 336 * MiB;
constexpr size_t WS_YQ = 336 * MiB;
constexpr size_t WS_Y3 = 336 * MiB;
constexpr size_t WS_Y5 = 32 * MiB;
constexpr size_t WS_END = 508 * MiB;

constexpr int CW_BAR = 4096;

constexpr int RING_BYTES = 131072;
constexpr int LDSCTL_OFF = RING_BYTES, MISC_OFF = LDSCTL_OFF + 320;
constexpr int PTR_OFF = LDSCTL_OFF + 1024;
constexpr int LDS_BYTES = 147456;
constexpr int NWAVES = 8, NTHR = 512;

#define GAS __attribute__((address_space(1)))
#define LAS __attribute__((address_space(3)))
typedef unsigned short bf16;
typedef float f32x4 __attribute__((ext_vector_type(4)));
typedef unsigned u32x4 __attribute__((ext_vector_type(4)));
typedef unsigned u32x2 __attribute__((ext_vector_type(2)));
typedef GAS unsigned gu32;

__device__ __forceinline__ unsigned f2bf(float f) { unsigned u = __builtin_bit_cast(unsigned, f); return (u + 0x7fffu + ((u >> 16) & 1u)) >> 16; }
__device__ __forceinline__ float bf2f(unsigned h) { return __builtin_bit_cast(float, h << 16); }
__device__ __forceinline__ unsigned pk2(float lo, float hi) { return f2bf(lo) | (f2bf(hi) << 16); }
__device__ __forceinline__ float hw_sin(float rev) { return __builtin_amdgcn_sinf(rev); }
__device__ __forceinline__ float hw_cos(float rev) { return __builtin_amdgcn_cosf(rev); }
__device__ const float INV_FREQ[16] = {1.0f, 0.5623413324356079f, 0.3162277638912201f, 0.17782793939113617f, 0.10000000149011612f, 0.05623413249850273f, 0.03162277489900589f, 0.017782794311642647f,
    0.009999999776482582f, 0.005623413249850273f, 0.003162277629598975f, 0.0017782794311642647f, 0.0010000000474974513f, 0.000562341301701963f, 0.0003162277571391314f, 0.00017782794020604342f};
__device__ __forceinline__ float wave_sum(float v) {
#pragma unroll
    for (int o = 1; o < 64; o <<= 1) v += __shfl_xor(v, o);
    return v;
}

#define XB_TMO      128
#define XB_XCNT(j)  (256  + 64 * (j))
#define XB_XSUB(j)  (1280 + 64 * (j))
#define XB_XGEN(j)  (2304 + 64 * (j))
#define XB_TOP      3328
#define XB_TOPGEN   3392
#define XCD_BAR_WORDS 3456
#define XB_SPIN_CAP (1u << 22)
__device__ __forceinline__ unsigned xb_ld(unsigned* p)              { return __hip_atomic_load(p, __ATOMIC_RELAXED, __HIP_MEMORY_SCOPE_AGENT); }
__device__ __forceinline__ unsigned xb_add(unsigned* p, unsigned v) { return __hip_atomic_fetch_add(p, v, __ATOMIC_RELAXED, __HIP_MEMORY_SCOPE_AGENT); }
__device__ __forceinline__ unsigned xb_xcc_id() { return (unsigned)__builtin_amdgcn_s_getreg((3 << 11) | 20) & 0xFu; }
#define XB_SPIN(cond, bar) do { unsigned _sp = 0; while (cond) { __builtin_amdgcn_s_sleep(1); \
    if ((++_sp & 255u) == 0u) { if (xb_ld(&(bar)[XB_TMO])) break; if (_sp > XB_SPIN_CAP) { atomicAdd(&(bar)[XB_TMO], 1u); break; } } } } while (0)
struct XcdBarrier { unsigned* bar; unsigned x; volatile LAS unsigned* st; };
__device__ __forceinline__ XcdBarrier xcd_barrier_post(unsigned* bar, volatile LAS unsigned* st) {
    XcdBarrier b; b.bar = bar; b.x = xb_xcc_id(); b.st = st;
    if (threadIdx.x == 0) (void)xb_add(&bar[XB_XCNT(b.x)], 1u);
    return b;
}
__device__ __forceinline__ void xcd_barrier_complete(unsigned* bar, unsigned x, unsigned& nloc, unsigned& nx) {
    const unsigned G = gridDim.x * gridDim.y * gridDim.z;
    unsigned sum, cnt, mine, sp = 0u;
    for (;;) {
        sum = 0u; cnt = 0u; mine = 0u;
#pragma unroll
        for (unsigned j = 0; j < 16; ++j) { const unsigned c = xb_ld(&bar[XB_XCNT(j)]); sum += c; cnt += (c > 0u) ? 1u : 0u; mine = (j == x) ? c : mine; }
        if (sum == G) break;
        __builtin_amdgcn_s_sleep(1);
        if ((++sp & 255u) == 0u) { if (xb_ld(&bar[XB_TMO])) break; if (sp > XB_SPIN_CAP) { atomicAdd(&bar[XB_TMO], 1u); break; } }
    }
    nloc = mine > 0u ? mine : 1u; nx = cnt > 0u ? cnt : 1u;
}
__device__ __forceinline__ void xcd_barrier(const XcdBarrier& b) {
    asm volatile("s_waitcnt vmcnt(0)" ::: "memory");
    __syncthreads();
    if (threadIdx.x == 0) {
        unsigned* bar = b.bar;
        __builtin_amdgcn_s_waitcnt(0);
        unsigned nloc = b.st[0], nx = b.st[1];
        if (nloc == 0u) { xcd_barrier_complete(bar, b.x, nloc, nx); b.st[0] = nloc; b.st[1] = nx; }
        const unsigned old = xb_add(&bar[XB_XSUB(b.x)], 1u);
        const unsigned gen = old / nloc;
        if (old + 1u == (gen + 1u) * nloc) {
            __builtin_amdgcn_fence(__ATOMIC_RELEASE, "agent");
            asm volatile("s_waitcnt vmcnt(0)" ::: "memory");
            const unsigned og = xb_add(&bar[XB_TOP], 1u);
            const unsigned tg = og / nx;
            if (og + 1u == (tg + 1u) * nx) xb_add(&bar[XB_TOPGEN], 1u);
            else XB_SPIN(xb_ld(&bar[XB_TOPGEN]) == tg, bar);
            __builtin_amdgcn_fence(__ATOMIC_ACQUIRE, "agent");
            xb_add(&bar[XB_XGEN(b.x)], 1u);
            asm volatile("s_waitcnt vmcnt(0)" ::: "memory");
        } else {
            XB_SPIN(xb_ld(&bar[XB_XGEN(b.x)]) == gen, bar);
            __builtin_amdgcn_fence(__ATOMIC_ACQUIRE, "agent");
            asm volatile("s_waitcnt vmcnt(0)" ::: "memory");
        }
    }
    __syncthreads();
}

struct Frame {
    unsigned char* lds;
    int tid, lane, wave, vcu, G;
    float* out; unsigned char* ws;
    __device__ __forceinline__ const float* inp(int k) const {
        const LAS unsigned* t = (const LAS unsigned*)((LAS unsigned char*)lds + PTR_OFF) + 2 * k;
        const unsigned lo = __builtin_amdgcn_readfirstlane(t[0]), hi = __builtin_amdgcn_readfirstlane(t[1]);
        return (const float*)(((unsigned long long)hi << 32) | lo);
    }
};
#define IN_X 0
#define IN_META 1
#define IN_G_PRE 2
#define IN_W_IN 3
#define IN_G_QA 4
#define IN_W_QB 5
#define IN_G_KVA 6
#define IN_W_KVB 7
#define IN_W_FOUR 8
#define IN_B_FOUR 9
#define IN_G_ATTN 10
#define IN_G_FOUR 11
#define IN_W_O 12
#define IN_G_POST 13
#define IN_G_PREFFN 14
#define IN_W_GATE 15
#define IN_W_UP 16
#define IN_W_DOWN 17
#define IN_G_POSTFFN 18

__device__ __forceinline__ void rms_row_to_bf16(const float* xrow, const float* gain, bf16* orow, int lane) {
    const f32x4* xr = (const f32x4*)xrow + lane; f32x4 v[4]; float s = 0.f;
#pragma unroll
    for (int j = 0; j < 4; ++j) { v[j] = xr[64 * j]; s += (v[j].x * v[j].x + v[j].y * v[j].y) + (v[j].z * v[j].z + v[j].w * v[j].w); }
    const float rstd = 1.0f / sqrtf(wave_sum(s) * (1.f / DM) + EPS);
    unsigned long long* o8 = (unsigned long long*)orow + lane;
#pragma unroll
    for (int j = 0; j < 4; ++j) { const f32x4 g = ((const f32x4*)gain)[lane + 64 * j];
        o8[64 * j] = (unsigned long long)pk2(v[j].x * rstd * g.x, v[j].y * rstd * g.y) | ((unsigned long long)pk2(v[j].z * rstd * g.z, v[j].w * rstd * g.w) << 32); }
}

__device__ __forceinline__ void ph_prologue(Frame& F) {
    const int gw = F.vcu * NWAVES + F.wave, NGW = F.G * NWAVES;
    bf16* XN = (bf16*)(F.ws + WS_XN);
    for (int r = gw; r < MNAT; r += NGW) {
        const int b = r / LTOK, l = r % LTOK;
        const float* src = l < NMETA ? F.inp(IN_META) + (size_t)l * DM : F.inp(IN_X) + ((size_t)b * SEQ + (l - NMETA)) * DM;
        rms_row_to_bf16(src, F.inp(IN_G_PRE), XN + (size_t)r * DM, F.lane);
    }
    const int gt = F.vcu * NTHR + F.tid, NGT = F.G * NTHR;
    float2* rope = (float2*)(F.ws + WS_ROPE);
    for (int i = gt; i < LTOK * 16; i += NGT) {
        const int l = i >> 4, j = i & 15;
        const float ang = (float)l * INV_FREQ[j];
        const double rev = (double)ang * 0.15915494309189535; const float fr = (float)(rev - floor(rev));
        rope[i] = make_float2(hw_cos(fr), hw_sin(fr));
    }
    float2* tw = (float2*)(F.ws + WS_TW);
    for (int i = gt; i < LTOK; i += NGT) { const float fr = (float)i / (float)LTOK; tw[i] = make_float2(hw_cos(fr), hw_sin(fr)); }
    float* WU = (float*)(F.ws + WS_WU);
    const float norm = 1.0f / sqrtf((float)LTOK * (float)FGD);
    for (int i = gt; i < 4 * 128 * 2 * 128; i += NGT) {
        const int d = i & 127, p = (i >> 7) & 1, c = (i >> 8) & 127, g = i >> 15;
        const float* wf = F.inp(IN_W_FOUR) + (size_t)g * 128 * 128 + d;
        float acc = 0.f;
        for (int j = 0; j < 128; ++j) { const float fr = (float)((c * j) & 127) * (1.0f / 128.0f); acc += (p ? -hw_sin(fr) : hw_cos(fr)) * wf[(size_t)j * 128]; }
        WU[i] = acc * norm;
    }
    bf16* KB = (bf16*)(F.ws + WS_KB); bf16* VB = (bf16*)(F.ws + WS_VB);
    for (int i = gt; i < 48 * 768; i += NGT) KB[(size_t)(META_ROW0 + 16) * 768 + i] = 0;
    for (int i = gt; i < 48 * 512; i += NGT) VB[(size_t)(META_ROW0 + 16) * 512 + i] = 0;
}

template <typename TA> __device__ __forceinline__ void sg_load_a4(const TA* p, float (&o)[4]);
template <> __device__ __forceinline__ void sg_load_a4<bf16>(const bf16* p, float (&o)[4]) { const u32x2 w = *(const u32x2*)p; o[0] = bf2f(w.x & 0xffffu); o[1] = bf2f(w.x >> 16); o[2] = bf2f(w.y & 0xffffu); o[3] = bf2f(w.y >> 16); }
template <> __device__ __forceinline__ void sg_load_a4<float>(const float* p, float (&o)[4]) { const f32x4 w = *(const f32x4*)p; o[0] = w.x; o[1] = w.y; o[2] = w.z; o[3] = w.w; }

template <bool DUAL, typename TA, class Epi>
__device__ __forceinline__ void sgemm(Frame& F, const TA* A, int lda, int M, const float* W0, const float* W1, int ldw, int N, int K, const Epi& epi) {
    float* As = (float*)F.lds;
    float* Bs0 = As + 16 * 132;
    const int tid = F.tid, tx = tid & 31, ty = tid >> 5;
    const int NT = DUAL ? 64 : 128;
    const int nMt = (M + 127) / 128, nNt = (N + NT - 1) / NT, items = nMt * nNt;
    for (int item = blockIdx.x; item < items; item += F.G) {
        const int m0 = (item / nNt) * 128, n0 = (item % nNt) * NT;
        float acc0[8][4];
#pragma unroll
        for (int i = 0; i < 8; ++i)
#pragma unroll
            for (int j = 0; j < 4; ++j) acc0[i][j] = 0.f;
        const int ar = tid >> 2, akq = (tid & 3) * 4, bk = tid >> 5, bt = tid & 31;
        const int bcol = DUAL ? n0 + (bt & 15) * 4 : n0 + bt * 4;
        const float* Wb = (DUAL && bt >= 16) ? W1 : W0;
        for (int k0 = 0; k0 < K; k0 += 16) {
            float av[4] = {0.f, 0.f, 0.f, 0.f};
            if (m0 + ar < M) sg_load_a4<TA>(A + (size_t)(m0 + ar) * lda + k0 + akq, av);
            f32x4 b0 = {0.f, 0.f, 0.f, 0.f};
            if (bcol < N) b0 = *(const f32x4*)(Wb + (size_t)(k0 + bk) * ldw + bcol);
            __syncthreads();
#pragma unroll
            for (int i = 0; i < 4; ++i) As[(akq + i) * 132 + ar] = av[i];
            *(f32x4*)(Bs0 + bk * 128 + bt * 4) = b0;
            __syncthreads();
#pragma unroll
            for (int kk = 0; kk < 16; ++kk) {
                const f32x4 a0 = *(const f32x4*)(As + kk * 132 + ty * 8), a1 = *(const f32x4*)(As + kk * 132 + ty * 8 + 4);
                const f32x4 bb0 = *(const f32x4*)(Bs0 + kk * 128 + tx * 4);
                const float a[8] = {a0.x, a0.y, a0.z, a0.w, a1.x, a1.y, a1.z, a1.w};
#pragma unroll
                for (int i = 0; i < 8; ++i) { acc0[i][0] += a[i] * bb0.x; acc0[i][1] += a[i] * bb0.y; acc0[i][2] += a[i] * bb0.z; acc0[i][3] += a[i] * bb0.w; }
            }
        }
        const int ecol = DUAL ? n0 + (tx & 15) * 4 : n0 + tx * 4;
#pragma unroll
        for (int i = 0; i < 8; ++i) {
            float other[4] = {0.f, 0.f, 0.f, 0.f};
            if (DUAL) {
#pragma unroll
                for (int j = 0; j < 4; ++j) other[j] = __shfl_xor(acc0[i][j], 16);
            }
            const int row = m0 + ty * 8 + i;
            if (row < M && ecol < N && (!DUAL || tx < 16)) epi(row, ecol, acc0[i], other);
        }
    }
    __syncthreads();
}
struct EpiStoreF32 { float* C; int ldc;
    __device__ __forceinline__ void operator()(int row, int col, const float (&v)[4], const float (&)[4]) const { *(f32x4*)(C + (size_t)row * ldc + col) = (f32x4){v[0], v[1], v[2], v[3]}; } };
struct EpiX0 { bf16* X0; int g;
    __device__ __forceinline__ void operator()(int row, int col, const float (&v)[4], const float (&)[4]) const {
        const int b = row / LTOK, l = row % LTOK, l1 = l / FN2, l2 = l % FN2;
#pragma unroll
        for (int i = 0; i < 4; ++i) { const int c = col + i, p = c >> 7, d = c & 127, cc = g * 128 + d;
            X0[((((size_t)b * 512 + cc) * FN2 + l2) * 2 + p) * 128 + l1] = (bf16)f2bf(v[i]); }
    } };
struct EpiSwiglu { bf16* ACT;
    __device__ __forceinline__ void operator()(int row, int col, const float (&g)[4], const float (&u)[4]) const {
        float o[4];
#pragma unroll
        for (int i = 0; i < 4; ++i) o[i] = g[i] / (1.0f + __expf(-g[i])) * u[i];
        *(u32x2*)(ACT + (size_t)row * DFF + col) = (u32x2){pk2(o[0], o[1]), pk2(o[2], o[3])};
    } };

__device__ __forceinline__ void ph_norms_s(Frame& F) {
    const int gw = F.vcu * NWAVES + F.wave, NGW = F.G * NWAVES, lane = F.lane;
    const float* Z = (const float*)(F.ws + WS_Z); bf16* ZQ = (bf16*)(F.ws + WS_ZQ); bf16* ZKV = (bf16*)(F.ws + WS_ZKV);
    const float2* rope = (const float2*)(F.ws + WS_ROPE);
    for (int r = gw; r < MNAT; r += NGW) {
        const int b = r / LTOK, l = r % LTOK; const float* z = Z + (size_t)r * INW;
        if (l >= NMETA) {
            const int xr = b * SEQ + l - NMETA;
            const f32x4 v = *(const f32x4*)(z + lane * 4);
            const float ss = wave_sum((v.x * v.x + v.y * v.y) + (v.z * v.z + v.w * v.w));
            const float rstd = 1.0f / sqrtf(ss * (1.f / QLR) + EPS);
            const f32x4 g = *(const f32x4*)(F.inp(IN_G_QA) + lane * 4);
            *(u32x2*)(ZQ + (size_t)xr * 256 + lane * 4) = (u32x2){pk2(v.x * rstd * g.x, v.y * rstd * g.y), pk2(v.z * rstd * g.z, v.w * rstd * g.w)};
        }
        const int kvrow = l >= NMETA ? b * SEQ + l - NMETA : (b == 0 ? META_ROW0 + l : -1);
        {
            const float v0 = z[256 + lane * 2], v1 = z[256 + lane * 2 + 1];
            const float ss = wave_sum(v0 * v0 + v1 * v1);
            const float rstd = 1.0f / sqrtf(ss * (1.f / KVLR) + EPS);
            if (kvrow >= 0) {
                bf16* o = ZKV + (size_t)kvrow * 256;
                *(unsigned*)(o + lane * 2) = pk2(v0 * rstd * F.inp(IN_G_KVA)[lane * 2], v1 * rstd * F.inp(IN_G_KVA)[lane * 2 + 1]);
                if (lane < 16) { const float x1 = z[384 + lane], x2 = z[400 + lane]; const float2 cs = rope[l * 16 + lane];
                    o[128 + lane] = (bf16)f2bf(x1 * cs.x - x2 * cs.y); o[144 + lane] = (bf16)f2bf(x2 * cs.x + x1 * cs.y); }
                o[160 + lane] = 0; if (lane < 32) o[224 + lane] = 0;
            }
        }
    }
}
__device__ __forceinline__ void ph_qpost_s(Frame& F) {
    const int gw = F.vcu * NWAVES + F.wave, NGW = F.G * NWAVES, lane = F.lane;
    const float* Y = (const float*)(F.ws + WS_YQ); bf16* Q = (bf16*)(F.ws + WS_Q); const float2* rope = (const float2*)(F.ws + WS_ROPE);
    for (int r = gw; r < MX; r += NGW) {
        const int l = (r % SEQ) + NMETA; const float* y = Y + (size_t)r * 768;
        for (int i = 0; i < 12; ++i) { const int col = lane + 64 * i, d = col % 96; float o;
            if (d < 64) o = y[col];
            else { const int j = d - 64; if (j < 16) { const float2 cs = rope[l * 16 + j]; o = y[col] * cs.x - y[col + 16] * cs.y; }
                   else { const float2 cs = rope[l * 16 + j - 16]; o = y[col] * cs.x + y[col - 16] * cs.y; } }
            Q[(size_t)r * 768 + col] = (bf16)f2bf(o * C2); }
    }
}
__device__ __forceinline__ void ph_kvpost_s(Frame& F) {
    const int gw = F.vcu * NWAVES + F.wave, NGW = F.G * NWAVES, lane = F.lane;
    const float* Y = (const float*)(F.ws + WS_YQ); bf16* KB = (bf16*)(F.ws + WS_KB); bf16* VB = (bf16*)(F.ws + WS_VB); const bf16* ZKV = (const bf16*)(F.ws + WS_ZKV);
    for (int r = gw; r < META_ROW0 + NMETA; r += NGW) {
        const float* y = Y + (size_t)r * 1024;
        for (int i = 0; i < 16; ++i) { const int col = lane + 64 * i, h = col >> 7, d = col & 127;
            if (d < 64) KB[(size_t)r * 768 + h * 96 + d] = (bf16)f2bf(y[col]); else VB[(size_t)r * 512 + h * 64 + d - 64] = (bf16)f2bf(y[col]); }
        for (int i = 0; i < 4; ++i) { const int idx = lane + 64 * i, h = idx >> 5, j = idx & 31; KB[(size_t)r * 768 + h * 96 + 64 + j] = ZKV[(size_t)r * 256 + 128 + j]; }
    }
}
__device__ __forceinline__ void ph_s1_s(Frame& F) {
    const int gw = F.vcu * NWAVES + F.wave, NGW = F.G * NWAVES, lane = F.lane;
    float* tab = (float*)F.lds;
    float* us = (float*)F.lds + 256 + F.wave * 256;
    for (int i = F.tid; i < FN1; i += NTHR) { const float fr = (float)i / (float)FN1; tab[i] = hw_cos(fr); tab[128 + i] = hw_sin(fr); }
    __syncthreads();
    const bf16* X0 = (const bf16*)(F.ws + WS_X0); bf16* X1 = (bf16*)(F.ws + WS_X1); const float2* tw = (const float2*)(F.ws + WS_TW);
    for (int it = gw; it < NB * 512 * FN2; it += NGW) {
        const int l2 = it % FN2, cc = (it / FN2) % 512, b = it / (FN2 * 512);
        const bf16* src = X0 + (size_t)it * 256;
        { const u32x2 w = *(const u32x2*)(src + lane * 4); us[lane * 4] = bf2f(w.x & 0xffffu); us[lane * 4 + 1] = bf2f(w.x >> 16); us[lane * 4 + 2] = bf2f(w.y & 0xffffu); us[lane * 4 + 3] = bf2f(w.y >> 16); }
        __builtin_amdgcn_wave_barrier(); asm volatile("s_waitcnt lgkmcnt(0)" ::: "memory");
        for (int k1 = lane; k1 < FN1; k1 += 64) {
            float ar = 0.f, ai = 0.f; int m = 0;
            for (int l1 = 0; l1 < FN1; ++l1) { const float c = tab[m], s = tab[128 + m], ur = us[l1], ui = us[128 + l1];
                ar += ur * c + ui * s; ai += ui * c - ur * s; m += k1; if (m >= FN1) m -= FN1; }
            const float2 t = tw[l2 * k1];
            const float br = ar * t.x + ai * t.y, bi = ai * t.x - ar * t.y;
            bf16* dst = X1 + ((((size_t)b * FN1 + k1) * 512 + cc) * 2) * 128 + l2;
            dst[0] = (bf16)f2bf(br); dst[128] = (bf16)f2bf(bi);
        }
        __builtin_amdgcn_wave_barrier(); asm volatile("s_waitcnt lgkmcnt(0)" ::: "memory");
    }
    __syncthreads();
}
__device__ __forceinline__ void ph_s2_s(Frame& F) {
    const int gw = F.vcu * NWAVES + F.wave, NGW = F.G * NWAVES, lane = F.lane;
    float* tab = (float*)F.lds; float* us = (float*)F.lds + 256 + F.wave * 256;
    for (int i = F.tid; i < FN2; i += NTHR) { const float fr = (float)i / (float)FN2; tab[i] = hw_cos(fr); tab[128 + i] = hw_sin(fr); }
    __syncthreads();
    const bf16* X1 = (const bf16*)(F.ws + WS_X1); bf16* AO = (bf16*)(F.ws + WS_AO);
    for (int it = gw; it < NB * FN1 * 512; it += NGW) {
        const int cc = it % 512, k1 = (it / 512) % FN1, b = it / (512 * FN1);
        const bf16* src = X1 + (size_t)it * 256;
        { const u32x2 w = *(const u32x2*)(src + lane * 4); us[lane * 4] = bf2f(w.x & 0xffffu); us[lane * 4 + 1] = bf2f(w.x >> 16); us[lane * 4 + 2] = bf2f(w.y & 0xffffu); us[lane * 4 + 3] = bf2f(w.y >> 16); }
        __builtin_amdgcn_wave_barrier(); asm volatile("s_waitcnt lgkmcnt(0)" ::: "memory");
        const float bias = F.inp(IN_B_FOUR)[cc];
        for (int k2 = lane; k2 < FN2; k2 += 64) {
            float y = 0.f; int m = 0;
            for (int l2 = 0; l2 < FN2; ++l2) { y += us[l2] * tab[m] + us[128 + l2] * tab[128 + m]; m += k2; if (m >= FN2) m -= FN2; }
            const int k = k1 + FN1 * k2;
            if (k >= NMETA) AO[((size_t)b * SEQ + k - NMETA) * 1024 + 512 + cc] = (bf16)f2bf(y + bias);
        }
        __builtin_amdgcn_wave_barrier(); asm volatile("s_waitcnt lgkmcnt(0)" ::: "memory");
    }
    __syncthreads();
}
__device__ __forceinline__ void ph_attn_s(Frame& F) {
    float* Ks = (float*)F.lds;
    float* Vs = Ks + 64 * 96;
    const bf16* Q = (const bf16*)(F.ws + WS_Q); const bf16* KB = (const bf16*)(F.ws + WS_KB); const bf16* VB = (const bf16*)(F.ws + WS_VB); bf16* AO = (bf16*)(F.ws + WS_AO);
    const int tid = F.tid, hf = tid & 1;
    for (int item = blockIdx.x; item < NB * NH * 32; item += F.G) {
        const int b = item >> 8, h = (item >> 5) & 7, qb = item & 31;
        const int xr = b * SEQ + qb * 256 + (tid >> 1);
        float q[48], o[32];
#pragma unroll
        for (int c = 0; c < 6; ++c) { const u32x4 w = *(const u32x4*)(Q + (size_t)xr * 768 + h * 96 + hf * 48 + c * 8);
            q[c * 8 + 0] = bf2f(w.x & 0xffffu); q[c * 8 + 1] = bf2f(w.x >> 16); q[c * 8 + 2] = bf2f(w.y & 0xffffu); q[c * 8 + 3] = bf2f(w.y >> 16);
            q[c * 8 + 4] = bf2f(w.z & 0xffffu); q[c * 8 + 5] = bf2f(w.z >> 16); q[c * 8 + 6] = bf2f(w.w & 0xffffu); q[c * 8 + 7] = bf2f(w.w >> 16); }
#pragma unroll
        for (int d = 0; d < 32; ++d) o[d] = 0.f;
        float m = -1e30f, l = 0.f;
        for (int tile = 0; tile < 129; ++tile) {
            const int nkeys = tile < 128 ? 64 : 16; const int krow0 = tile < 128 ? b * SEQ + tile * 64 : META_ROW0;
            __syncthreads();
            for (int c = tid; c < 768; c += NTHR) { const int row = c / 12, part = c % 12;
                if (row < nkeys) { const u32x4 w = *(const u32x4*)(KB + (size_t)(krow0 + row) * 768 + h * 96 + part * 8); float* dst = Ks + row * 96 + part * 8;
                    dst[0] = bf2f(w.x & 0xffffu); dst[1] = bf2f(w.x >> 16); dst[2] = bf2f(w.y & 0xffffu); dst[3] = bf2f(w.y >> 16);
                    dst[4] = bf2f(w.z & 0xffffu); dst[5] = bf2f(w.z >> 16); dst[6] = bf2f(w.w & 0xffffu); dst[7] = bf2f(w.w >> 16); } }
            { const int row = tid >> 3, part = tid & 7;
                if (row < nkeys) { const u32x4 w = *(const u32x4*)(VB + (size_t)(krow0 + row) * 512 + h * 64 + part * 8); float* dst = Vs + row * 64 + part * 8;
                    dst[0] = bf2f(w.x & 0xffffu); dst[1] = bf2f(w.x >> 16); dst[2] = bf2f(w.y & 0xffffu); dst[3] = bf2f(w.y >> 16);
                    dst[4] = bf2f(w.z & 0xffffu); dst[5] = bf2f(w.z >> 16); dst[6] = bf2f(w.w & 0xffffu); dst[7] = bf2f(w.w >> 16); } }
            __syncthreads();
            for (int j0 = 0; j0 < nkeys; j0 += 8) {
                float s[8];
#pragma unroll
                for (int jj = 0; jj < 8; ++jj) { const float* kr = Ks + (j0 + jj) * 96 + hf * 48; float a = 0.f;
#pragma unroll
                    for (int d = 0; d < 48; ++d) a += q[d] * kr[d];
                    s[jj] = a + __shfl_xor(a, 1); }
                float cm = s[0];
#pragma unroll
                for (int jj = 1; jj < 8; ++jj) cm = fmaxf(cm, s[jj]);
                const float mn = fmaxf(m, cm), alpha = exp2f(m - mn); m = mn; l *= alpha;
#pragma unroll
                for (int d = 0; d < 32; ++d) o[d] *= alpha;
#pragma unroll
                for (int jj = 0; jj < 8; ++jj) { const float p = exp2f(s[jj] - m); l += p; const float* vr = Vs + (j0 + jj) * 64 + hf * 32;
#pragma unroll
                    for (int d = 0; d < 32; ++d) o[d] += p * vr[d]; }
            }
        }
        const float rl = 1.0f / l;
#pragma unroll
        for (int c = 0; c < 4; ++c) { u32x4 w; w.x = pk2(o[c * 8] * rl, o[c * 8 + 1] * rl); w.y = pk2(o[c * 8 + 2] * rl, o[c * 8 + 3] * rl); w.z = pk2(o[c * 8 + 4] * rl, o[c * 8 + 5] * rl); w.w = pk2(o[c * 8 + 6] * rl, o[c * 8 + 7] * rl);
            *(u32x4*)(AO + (size_t)xr * 1024 + h * 64 + hf * 32 + c * 8) = w; }
    }
    __syncthreads();
}
__device__ __forceinline__ void ph_mrg_s(Frame& F) {
    const int gw = F.vcu * NWAVES + F.wave, NGW = F.G * NWAVES, lane = F.lane;
    const bf16* AO = (const bf16*)(F.ws + WS_AO); bf16* MRG = (bf16*)(F.ws + WS_MRG);
    for (int r = gw; r < MX; r += NGW) {
#pragma unroll
        for (int half = 0; half < 2; ++half) {
            const u32x4 w = *(const u32x4*)(AO + (size_t)r * 1024 + half * 512 + lane * 8);
            float v[8] = {bf2f(w.x & 0xffffu), bf2f(w.x >> 16), bf2f(w.y & 0xffffu), bf2f(w.y >> 16), bf2f(w.z & 0xffffu), bf2f(w.z >> 16), bf2f(w.w & 0xffffu), bf2f(w.w >> 16)};
            float ss = 0.f;
#pragma unroll
            for (int i = 0; i < 8; ++i) ss += v[i] * v[i];
            const float rstd = 1.0f / sqrtf(wave_sum(ss) * (1.f / 512.f) + EPS);
            const float* g = (half ? F.inp(IN_G_FOUR) : F.inp(IN_G_ATTN)) + lane * 8;
            u32x4 o; o.x = pk2(v[0] * rstd * g[0], v[1] * rstd * g[1]); o.y = pk2(v[2] * rstd * g[2], v[3] * rstd * g[3]); o.z = pk2(v[4] * rstd * g[4], v[5] * rstd * g[5]); o.w = pk2(v[6] * rstd * g[6], v[7] * rstd * g[7]);
            *(u32x4*)(MRG + (size_t)r * 1024 + half * 512 + lane * 8) = o;
        }
    }
}
__device__ __forceinline__ void ph_wopost_s(Frame& F) {
    const int gw = F.vcu * NWAVES + F.wave, NGW = F.G * NWAVES, lane = F.lane;
    const float* Y = (const float*)(F.ws + WS_Y3); bf16* XN2 = (bf16*)(F.ws + WS_XN);
    for (int r = gw; r < MX; r += NGW) {
        const f32x4* yr = (const f32x4*)(Y + (size_t)r * DM) + lane; const f32x4* xr = (const f32x4*)(F.inp(IN_X) + (size_t)r * DM) + lane;
        f32x4 v[4]; float s = 0.f;
#pragma unroll
        for (int j = 0; j < 4; ++j) { v[j] = yr[64 * j]; s += (v[j].x * v[j].x + v[j].y * v[j].y) + (v[j].z * v[j].z + v[j].w * v[j].w); }
        const float rstd = 1.0f / sqrtf(wave_sum(s) * (1.f / DM) + EPS);
        float s2 = 0.f;
#pragma unroll
        for (int j = 0; j < 4; ++j) { const f32x4 g = ((const f32x4*)F.inp(IN_G_POST))[lane + 64 * j]; v[j] = xr[64 * j] + v[j] * rstd * g;
            s2 += (v[j].x * v[j].x + v[j].y * v[j].y) + (v[j].z * v[j].z + v[j].w * v[j].w); ((f32x4*)(F.out + (size_t)r * DM))[lane + 64 * j] = v[j]; }
        const float rstd2 = 1.0f / sqrtf(wave_sum(s2) * (1.f / DM) + EPS);
        unsigned long long* o8 = (unsigned long long*)(XN2 + (size_t)r * DM) + lane;
#pragma unroll
        for (int j = 0; j < 4; ++j) { const f32x4 g = ((const f32x4*)F.inp(IN_G_PREFFN))[lane + 64 * j];
            o8[64 * j] = (unsigned long long)pk2(v[j].x * rstd2 * g.x, v[j].y * rstd2 * g.y) | ((unsigned long long)pk2(v[j].z * rstd2 * g.z, v[j].w * rstd2 * g.w) << 32); }
    }
}
__device__ __forceinline__ void ph_dnpost_s(Frame& F) {
    const int gw = F.vcu * NWAVES + F.wave, NGW = F.G * NWAVES, lane = F.lane;
    const float* Y = (const float*)(F.ws + WS_Y5);
    for (int r = gw; r < MX; r += NGW) {
        const f32x4* yr = (const f32x4*)(Y + (size_t)r * DM) + lane; f32x4* orow = (f32x4*)(F.out + (size_t)r * DM) + lane;
        f32x4 v[4]; float s = 0.f;
#pragma unroll
        for (int j = 0; j < 4; ++j) { v[j] = yr[64 * j]; s += (v[j].x * v[j].x + v[j].y * v[j].y) + (v[j].z * v[j].z + v[j].w * v[j].w); }
        const float rstd = 1.0f / sqrtf(wave_sum(s) * (1.f / DM) + EPS);
#pragma unroll
        for (int j = 0; j < 4; ++j) { const f32x4 g = ((const f32x4*)F.inp(IN_G_POSTFFN))[lane + 64 * j]; orow[64 * j] = orow[64 * j] + v[j] * rstd * g; }
    }
}

enum Phase { PH_PRO = 0, PH_INPROJ_S, PH_NORMS_S, PH_U_S, PH_Q_S, PH_QPOST_S, PH_KV_S, PH_KVPOST_S, PH_S1_S, PH_S2_S, PH_ATTN_S, PH_MRG_S, PH_WO_S, PH_WOPOST_S, PH_GU_S, PH_DN_S, PH_DNPOST_S, PH_COUNT };

struct Args { const float* in[19]; float* out; unsigned char* ws; int ph_lo, ph_hi, use_bar, pad; };

__global__ void __launch_bounds__(NTHR, 2) mega_fwd(Args args) {
    extern __shared__ __attribute__((aligned(16))) unsigned char lds[];
    Frame F;
    F.lds = lds; F.tid = threadIdx.x; F.lane = F.tid & 63; F.wave = __builtin_amdgcn_readfirstlane(F.tid >> 6);
    F.G = gridDim.x; { const int bx = blockIdx.x; F.vcu = (F.G % 8 == 0) ? (bx % 8) * (F.G / 8) + bx / 8 : bx; }
    F.out = args.out; F.ws = args.ws;
    volatile LAS unsigned* MISC = (volatile LAS unsigned*)((LAS unsigned char*)lds + MISC_OFF);
    for (int u = F.tid; u < (LDS_BYTES - LDSCTL_OFF) / 4; u += NTHR) ((LAS unsigned*)((LAS unsigned char*)lds + LDSCTL_OFF))[u] = 0u;
    if (F.tid < 19) { const unsigned long long p = (unsigned long long)args.in[F.tid]; LAS unsigned* t = (LAS unsigned*)((LAS unsigned char*)lds + PTR_OFF) + 2 * F.tid; t[0] = (unsigned)p; t[1] = (unsigned)(p >> 32); }
    __syncthreads();
    XcdBarrier bar; bar.bar = (unsigned*)(F.ws + WS_CTL) + CW_BAR; bar.x = 0; bar.st = nullptr;
    if (args.use_bar) bar = xcd_barrier_post((unsigned*)(F.ws + WS_CTL) + CW_BAR, MISC + 8);

    const int lo = args.ph_lo, hi = args.ph_hi;
#define PHASE(k, ...) do { if (lo <= (k) && (k) < hi) { __VA_ARGS__; if ((k) + 1 < hi) xcd_barrier(bar); } } while (0)
    PHASE(PH_PRO, ph_prologue(F));
    PHASE(PH_INPROJ_S, (sgemm<false, bf16>(F, (const bf16*)(F.ws + WS_XN), DM, MNAT, F.inp(IN_W_IN), nullptr, INW, INW, DM, EpiStoreF32{(float*)(F.ws + WS_Z), INW})));
    PHASE(PH_NORMS_S, ph_norms_s(F));
    PHASE(PH_U_S, { for (int g = 0; g < 4; ++g) sgemm<false, float>(F, (const float*)(F.ws + WS_Z) + 416 + g * 128, INW, MNAT, (const float*)(F.ws + WS_WU) + (size_t)g * 128 * 256, nullptr, 256, 256, 128, EpiX0{(bf16*)(F.ws + WS_X0), g}); });
    PHASE(PH_Q_S, (sgemm<false, bf16>(F, (const bf16*)(F.ws + WS_ZQ), 256, MX, F.inp(IN_W_QB), nullptr, 768, 768, 256, EpiStoreF32{(float*)(F.ws + WS_YQ), 768})));
    PHASE(PH_QPOST_S, ph_qpost_s(F));
    PHASE(PH_KV_S, (sgemm<false, bf16>(F, (const bf16*)(F.ws + WS_ZKV), 256, META_ROW0 + NMETA, F.inp(IN_W_KVB), nullptr, 1024, 1024, 128, EpiStoreF32{(float*)(F.ws + WS_YQ), 1024})));
    PHASE(PH_KVPOST_S, ph_kvpost_s(F));
    PHASE(PH_S1_S, ph_s1_s(F));
    PHASE(PH_S2_S, ph_s2_s(F));
    PHASE(PH_ATTN_S, ph_attn_s(F));
    PHASE(PH_MRG_S, ph_mrg_s(F));
    PHASE(PH_WO_S, (sgemm<false, bf16>(F, (const bf16*)(F.ws + WS_MRG), DM, MX, F.inp(IN_W_O), nullptr, DM, DM, DM, EpiStoreF32{(float*)(F.ws + WS_Y3), DM})));
    PHASE(PH_WOPOST_S, ph_wopost_s(F));
    PHASE(PH_GU_S, (sgemm<true, bf16>(F, (const bf16*)(F.ws + WS_XN), DM, MX, F.inp(IN_W_GATE), F.inp(IN_W_UP), DFF, DFF, DM, EpiSwiglu{(bf16*)(F.ws + WS_ACT)})));
    PHASE(PH_DN_S, (sgemm<false, bf16>(F, (const bf16*)(F.ws + WS_ACT), DFF, MX, F.inp(IN_W_DOWN), nullptr, DM, DM, DFF, EpiStoreF32{(float*)(F.ws + WS_Y5), DM})));
    PHASE(PH_DNPOST_S, ph_dnpost_s(F));
#undef PHASE
}

#ifndef MK_ONE_LAUNCH
#define MK_ONE_LAUNCH 1
#endif
extern "C" void kernel_launch(void* const* d_in, const int* in_sizes, int n_in, void* d_out, int out_size, void* d_ws, size_t ws_size, hipStream_t stream) {
    static int grid = 0;
    if (grid == 0) {
        if (n_in != 19 || out_size != MX * DM || ws_size < WS_END) { fprintf(stderr, "kernel_launch: unexpected shapes n_in %d out %d ws %zu\n", n_in, out_size, ws_size); grid = -1; return; }
        int dev = 0, cus = 0, per_cu = 0;
        hipGetDevice(&dev); hipDeviceGetAttribute(&cus, hipDeviceAttributeMultiprocessorCount, dev);
        if (hipFuncSetAttribute((const void*)mega_fwd, hipFuncAttributeMaxDynamicSharedMemorySize, LDS_BYTES) != hipSuccess) { fprintf(stderr, "kernel_launch: hipFuncSetAttribute failed\n"); grid = -1; return; }
        if (hipOccupancyMaxActiveBlocksPerMultiprocessor(&per_cu, (const void*)mega_fwd, NTHR, LDS_BYTES) != hipSuccess || per_cu < 1) { fprintf(stderr, "kernel_launch: occupancy query gives %d\n", per_cu); per_cu = 1; }
        (void)hipGetLastError();
        grid = cus * 1;
        fprintf(stderr, "kernel_launch: cus %d per_cu %d grid %d ws %zu\n", cus, per_cu, grid, ws_size);
    }
    if (grid < 0) return;
    hipMemsetAsync((char*)d_ws + WS_CTL, 0, CTL_ZERO_BYTES, stream);
    Args a{};
    for (int i = 0; i < 19; ++i) a.in[i] = (const float*)d_in[i];
    a.out = (float*)d_out; a.ws = (unsigned char*)d_ws;
#if MK_ONE_LAUNCH
    a.ph_lo = 0; a.ph_hi = PH_COUNT; a.use_bar = 1;
    void* kargs[] = {&a};
    hipError_t e = hipLaunchCooperativeKernel((const void*)mega_fwd, dim3(grid), dim3(NTHR), kargs, LDS_BYTES, stream);
    if (e != hipSuccess) fprintf(stderr, "kernel_launch: cooperative launch failed: %s\n", hipGetErrorString(e));
#else
    for (int ph = 0; ph < PH_COUNT; ++ph) {
        a.ph_lo = ph; a.ph_hi = ph + 1; a.use_bar = 0;
        hipLaunchKernelGGL(mega_fwd, dim3(grid), dim3(NTHR), LDS_BYTES, stream, a);
    }
#endif
}
```

```cpp
#include <hip/hip_runtime.h>
#include <cstdio>
#include <cstdint>

constexpr int NB = 4, SEQ = 8192, LTOK = 8208, DM = 1024, NMETA = 16;
constexpr int MX = NB * SEQ;
constexpr int MNAT = NB * LTOK;
constexpr int INW = 928, QLR = 256, KVLR = 128, ROPED = 32, NH = 8, DQK = 96, DV = 64;
constexpr int FW = 512, FGD = 128;
constexpr int DFF = 2816;
constexpr int FN1 = 108, FN2 = 76;
constexpr int KVROWS = 33024;
constexpr int META_ROW0 = 32768;
constexpr float EPS = 1e-6f;
constexpr float C2 = 0.10206207261596577f * 1.4426950408889634f;

constexpr size_t MiB = 1u << 20;
constexpr size_t WS_CTL = 0, CTL_ZERO_BYTES = 1 * MiB;
constexpr size_t WS_ROPE = 1 * MiB;
constexpr size_t WS_TW = 3 * MiB;
constexpr size_t WS_WU = 4 * MiB;
constexpr size_t WS_WIN = 5 * MiB;
constexpr size_t WS_WQB = 8 * MiB;
constexpr size_t WS_WKV = 9 * MiB;
constexpr size_t WS_WO = 10 * MiB;
constexpr size_t WS_WGU = 12 * MiB;
constexpr size_t WS_WDN = 23 * MiB;
constexpr size_t WS_DD1 = 29 * MiB;
constexpr size_t WS_D2 = 30 * MiB;
constexpr size_t WS_XN = 32 * MiB;
constexpr size_t WS_ZQ = 97 * MiB;
constexpr size_t WS_ZKV = 113 * MiB;
constexpr size_t WS_Q = 130 * MiB;
constexpr size_t WS_KB = 178 * MiB;
constexpr size_t WS_VB = 227 * MiB;
constexpr size_t WS_X0 = 260 * MiB;
constexpr size_t WS_X1 = 336 * MiB;
constexpr size_t WS_AO = 444 * MiB;
constexpr size_t WS_MRG = 130 * MiB;
constexpr size_t WS_ACT = 260 * MiB;
constexpr size_t WS_Z = 336 * MiB;
constexpr size_t WS_YQ = 336 * MiB;
constexpr size_t WS_Y3 = 336 * MiB;
constexpr size_t WS_Y5 = 32 * MiB;
constexpr size_t WS_END = 508 * MiB;

constexpr int CW_BAR = 4096;

constexpr int RING_BYTES = 131072;
constexpr int LDSCTL_OFF = RING_BYTES, MISC_OFF = LDSCTL_OFF + 320;
constexpr int PTR_OFF = LDSCTL_OFF + 1024;
constexpr int LDS_BYTES = 147456;
constexpr int NWAVES = 8, NTHR = 512;

#define GAS __attribute__((address_space(1)))
#define LAS __attribute__((address_space(3)))
typedef unsigned short bf16;
typedef float f32x4 __attribute__((ext_vector_type(4)));
typedef unsigned u32x4 __attribute__((ext_vector_type(4)));
typedef unsigned u32x2 __attribute__((ext_vector_type(2)));
typedef GAS unsigned gu32;

__device__ __forceinline__ unsigned f2bf(float f) { unsigned u = __builtin_bit_cast(unsigned, f); return (u + 0x7fffu + ((u >> 16) & 1u)) >> 16; }
__device__ __forceinline__ float bf2f(unsigned h) { return __builtin_bit_cast(float, h << 16); }
__device__ __forceinline__ unsigned pk2(float lo, float hi) { return f2bf(lo) | (f2bf(hi) << 16); }
__device__ __forceinline__ float hw_sin(float rev) { return __builtin_amdgcn_sinf(rev); }
__device__ __forceinline__ float hw_cos(float rev) { return __builtin_amdgcn_cosf(rev); }
__device__ const float INV_FREQ[16] = {1.0f, 0.5623413324356079f, 0.3162277638912201f, 0.17782793939113617f, 0.10000000149011612f, 0.05623413249850273f, 0.03162277489900589f, 0.017782794311642647f,
    0.009999999776482582f, 0.005623413249850273f, 0.003162277629598975f, 0.0017782794311642647f, 0.0010000000474974513f, 0.000562341301701963f, 0.0003162277571391314f, 0.00017782794020604342f};
__device__ __forceinline__ float wave_sum(float v) {
#pragma unroll
    for (int o = 1; o < 64; o <<= 1) v += __shfl_xor(v, o);
    return v;
}

#define XB_TMO      128
#define XB_XCNT(j)  (256  + 64 * (j))
#define XB_XSUB(j)  (1280 + 64 * (j))
#define XB_XGEN(j)  (2304 + 64 * (j))
#define XB_TOP      3328
#define XB_TOPGEN   3392
#define XCD_BAR_WORDS 3456
#define XB_SPIN_CAP (1u << 22)
__device__ __forceinline__ unsigned xb_ld(unsigned* p)              { return __hip_atomic_load(p, __ATOMIC_RELAXED, __HIP_MEMORY_SCOPE_AGENT); }
__device__ __forceinline__ unsigned xb_add(unsigned* p, unsigned v) { return __hip_atomic_fetch_add(p, v, __ATOMIC_RELAXED, __HIP_MEMORY_SCOPE_AGENT); }
__device__ __forceinline__ unsigned xb_xcc_id() { return (unsigned)__builtin_amdgcn_s_getreg((3 << 11) | 20) & 0xFu; }
#define XB_SPIN(cond, bar) do { unsigned _sp = 0; while (cond) { __builtin_amdgcn_s_sleep(1); \
    if ((++_sp & 255u) == 0u) { if (xb_ld(&(bar)[XB_TMO])) break; if (_sp > XB_SPIN_CAP) { atomicAdd(&(bar)[XB_TMO], 1u); break; } } } } while (0)
struct XcdBarrier { unsigned* bar; unsigned x; volatile LAS unsigned* st; };
__device__ __forceinline__ XcdBarrier xcd_barrier_post(unsigned* bar, volatile LAS unsigned* st) {
    XcdBarrier b; b.bar = bar; b.x = xb_xcc_id(); b.st = st;
    if (threadIdx.x == 0) (void)xb_add(&bar[XB_XCNT(b.x)], 1u);
    return b;
}
__device__ __forceinline__ void xcd_barrier_complete(unsigned* bar, unsigned x, unsigned& nloc, unsigned& nx) {
    const unsigned G = gridDim.x * gridDim.y * gridDim.z;
    unsigned sum, cnt, mine, sp = 0u;
    for (;;) {
        sum = 0u; cnt = 0u; mine = 0u;
#pragma unroll
        for (unsigned j = 0; j < 16; ++j) { const unsigned c = xb_ld(&bar[XB_XCNT(j)]); sum += c; cnt += (c > 0u) ? 1u : 0u; mine = (j == x) ? c : mine; }
        if (sum == G) break;
        __builtin_amdgcn_s_sleep(1);
        if ((++sp & 255u) == 0u) { if (xb_ld(&bar[XB_TMO])) break; if (sp > XB_SPIN_CAP) { atomicAdd(&bar[XB_TMO], 1u); break; } }
    }
    nloc = mine > 0u ? mine : 1u; nx = cnt > 0u ? cnt : 1u;
}
__device__ __forceinline__ void xcd_barrier(const XcdBarrier& b) {
    asm volatile("s_waitcnt vmcnt(0)" ::: "memory");
    __syncthreads();
    if (threadIdx.x == 0) {
        unsigned* bar = b.bar;
        __builtin_amdgcn_s_waitcnt(0);
        unsigned nloc = b.st[0], nx = b.st[1];
        if (nloc == 0u) { xcd_barrier_complete(bar, b.x, nloc, nx); b.st[0] = nloc; b.st[1] = nx; }
        const unsigned old = xb_add(&bar[XB_XSUB(b.x)], 1u);
        const unsigned gen = old / nloc;
        if (old + 1u == (gen + 1u) * nloc) {
            __builtin_amdgcn_fence(__ATOMIC_RELEASE, "agent");
            asm volatile("s_waitcnt vmcnt(0)" ::: "memory");
            const unsigned og = xb_add(&bar[XB_TOP], 1u);
            const unsigned tg = og / nx;
            if (og + 1u == (tg + 1u) * nx) xb_add(&bar[XB_TOPGEN], 1u);
            else XB_SPIN(xb_ld(&bar[XB_TOPGEN]) == tg, bar);
            __builtin_amdgcn_fence(__ATOMIC_ACQUIRE, "agent");
            xb_add(&bar[XB_XGEN(b.x)], 1u);
            asm volatile("s_waitcnt vmcnt(0)" ::: "memory");
        } else {
            XB_SPIN(xb_ld(&bar[XB_XGEN(b.x)]) == gen, bar);
            __builtin_amdgcn_fence(__ATOMIC_ACQUIRE, "agent");
            asm volatile("s_waitcnt vmcnt(0)" ::: "memory");
        }
    }
    __syncthreads();
}

struct Frame {
    unsigned char* lds;
    int tid, lane, wave, vcu, G;
    float* out; unsigned char* ws;
    __device__ __forceinline__ const float* inp(int k) const {
        const LAS unsigned* t = (const LAS unsigned*)((LAS unsigned char*)lds + PTR_OFF) + 2 * k;
        const unsigned lo = __builtin_amdgcn_readfirstlane(t[0]), hi = __builtin_amdgcn_readfirstlane(t[1]);
        return (const float*)(((unsigned long long)hi << 32) | lo);
    }
};
#define IN_X 0
#define IN_META 1
#define IN_G_PRE 2
#define IN_W_IN 3
#define IN_G_QA 4
#define IN_W_QB 5
#define IN_G_KVA 6
#define IN_W_KVB 7
#define IN_W_FOUR 8
#define IN_B_FOUR 9
#define IN_G_ATTN 10
#define IN_G_FOUR 11
#define IN_W_O 12
#define IN_G_POST 13
#define IN_G_PREFFN 14
#define IN_W_GATE 15
#define IN_W_UP 16
#define IN_W_DOWN 17
#define IN_G_POSTFFN 18


namespace pg8 {
#define PG8_LAS __attribute__((address_space(3)))
typedef unsigned short bf16_t;
typedef short bf16x8 __attribute__((ext_vector_type(8)));
typedef float f32x4 __attribute__((ext_vector_type(4)));
typedef unsigned u32x4 __attribute__((ext_vector_type(4)));
constexpr int BM = 256, BK = 64, HALF = 128, HTB = HALF * BK * 2, STAGE_BYTES = 8 * HTB, NXCD = 8, WGM = 8;
__host__ __device__ __forceinline__ int lds_byte(int r, int c) { const int st = (r >> 4) * 2 + (c >> 5), rr = r & 15, cc = c & 31, ob = rr * 64 + cc * 2; return st * 1024 + (ob ^ (((ob >> 9) & 1) << 5)); }
__host__ __device__ __forceinline__ void stage_rc(int b, int& R, int& C) { const int st = b / 1024, sb = b % 1024, swz = sb ^ (((sb >> 9) & 1) << 5); R = (st >> 1) * 16 + swz / 64; C = (st & 1) * 32 + (swz % 64) / 2; }
__host__ __device__ __forceinline__ int perm32(int rho) { const int n = rho >> 4, i = rho & 15; return 8 * (i >> 2) + 4 * n + (i & 3); }

struct Unit { int pm, pn; const char* a; const char* b; };
struct Gemm { int K; size_t hstepA, hstepB; int a_rowbytes, a_rclamp; };

struct StaticOrder {
    int nM, nN, nwg, G, c; const char* A; const char* Bt; size_t tstepA, tstepB;
    __device__ void init(const void* A_, const void* Bt_, int M, int N, int K, int G_, int c_) { nM = M / BM; nN = N / BM; nwg = nM * nN; G = G_; c = c_; A = (const char*)A_; Bt = (const char*)Bt_; tstepA = (size_t)BM * K * 2; tstepB = tstepA; }
    __device__ bool next(int i, Unit& u) const {
        const long L = (long)i * G + c; if (L >= nwg) return false;
        int wgid = (int)L; { const int q = nwg / NXCD, r = nwg % NXCD, xcd = wgid % NXCD, off = wgid / NXCD; wgid = (xcd < r ? xcd * (q + 1) : r * (q + 1) + (xcd - r) * q) + off; }
        const int nig = WGM * nN, gid = wgid / nig, fm = gid * WGM, gsz = (nM - fm) < WGM ? (nM - fm) : WGM;
        u.pm = fm + ((wgid % nig) % gsz); u.pn = (wgid % nig) / gsz; u.a = A + (size_t)u.pm * tstepA; u.b = Bt + (size_t)u.pn * tstepB; return true;
    }
};

__device__ __forceinline__ unsigned cvt_pk_bf16(float lo, float hi) { unsigned r; asm volatile("v_cvt_pk_bf16_f32 %0, %1, %2" : "=v"(r) : "v"(lo), "v"(hi)); return r; }

struct EpiF32 {
    static constexpr bool PERM = false;
    float* C; int ldc;
    __device__ __forceinline__ void operator()(const f32x4 (&acc)[2][2][4][2], const Unit& u, int wr, int wc, int fr, int fq) const {
        const int row0 = u.pm * BM + wr * 64 + fr, col0 = u.pn * BM + wc * 32 + 4 * fq;
#pragma unroll
        for (int ai = 0; ai < 2; ++ai)
#pragma unroll
            for (int m = 0; m < 4; ++m) { float* rowp = C + (size_t)(row0 + ai * HALF + m * 16) * ldc + col0;
#pragma unroll
                for (int bj = 0; bj < 2; ++bj)
#pragma unroll
                    for (int n = 0; n < 2; ++n) *(f32x4*)(rowp + bj * HALF + n * 16) = acc[ai][bj][m][n]; }
    }
};
struct EpiSwigluF {
    static constexpr bool PERM = true;
    bf16_t* O; int ldc;
    __device__ __forceinline__ void operator()(const f32x4 (&acc)[2][2][4][2], const Unit& u, int wr, int wc, int fr, int fq) const {
        const int row0 = u.pm * BM + wr * 64 + fr, col0 = u.pn * HALF + wc * 32 + 8 * fq;
#pragma unroll
        for (int ai = 0; ai < 2; ++ai)
#pragma unroll
            for (int m = 0; m < 4; ++m) { bf16_t* rowp = O + (size_t)(row0 + ai * HALF + m * 16) * ldc + col0;
                float o[8];
#pragma unroll
                for (int n = 0; n < 2; ++n)
#pragma unroll
                    for (int j = 0; j < 4; ++j) { const float g = acc[ai][0][m][n][j], up = acc[ai][1][m][n][j]; o[n * 4 + j] = g * __builtin_amdgcn_rcpf(1.0f + __builtin_amdgcn_exp2f(-1.4426950408889634f * g)) * up; }
                u32x4 w; w.x = cvt_pk_bf16(o[0], o[1]); w.y = cvt_pk_bf16(o[2], o[3]); w.z = cvt_pk_bf16(o[4], o[5]); w.w = cvt_pk_bf16(o[6], o[7]);
                *(u32x4*)rowp = w; }
    }
};

template <class Epi, class Sched>
__device__ __forceinline__ void gemm_phase(PG8_LAS unsigned char* lds, const Gemm g, const Sched& S, const Epi& E) {
    const int tid = threadIdx.x, wid = __builtin_amdgcn_readfirstlane(tid >> 6), lane = tid & 63, wr = wid >> 2, wc = wid & 3, fr = lane & 15, fq = lane >> 4;
    const int K = g.K, nt = K / BK;
    unsigned voffA[2], voffB[2];
#pragma unroll
    for (int i = 0; i < 2; ++i) { int R, C; stage_rc(tid * 16 + i * 8192, R, C); const int Rb = Epi::PERM ? ((R & ~31) + perm32(R & 31)) : R; const int Ra = R < g.a_rclamp ? R : g.a_rclamp;
        voffA[i] = (unsigned)(Ra * g.a_rowbytes + C * 2); voffB[i] = (unsigned)(Rb * K + C) * 2u; }
    const size_t kstep = (size_t)(BK * 2);
    const size_t hstepA = g.hstepA, hstepB = g.hstepB;
    const unsigned ldsw = (unsigned)wid * 1024u;
    const int aoff = lds_byte(wr * 64 + fr, fq * 8), boff = lds_byte(wc * 32 + fr, fq * 8);
#define PG8_SA(b, h) (((b) * 2 + (h)) * HTB)
#define PG8_SB(b, h) ((4 + (b) * 2 + (h)) * HTB)
#define PG8_STAGE(bufoff, gbase, voff) do { _Pragma("unroll") for (int _i = 0; _i < 2; ++_i) \
        __builtin_amdgcn_global_load_lds((const unsigned*)((const char*)(gbase) + (voff)[_i]), (PG8_LAS unsigned*)(lds + (bufoff) + ldsw + _i * 8192), 16, 0, 0); } while (0)
#define PG8_LDA(dst, b, h) do { _Pragma("unroll") for (int m = 0; m < 4; ++m) _Pragma("unroll") for (int k = 0; k < 2; ++k) dst[m][k] = *(const PG8_LAS bf16x8*)(lds + PG8_SA(b, h) + aoff + m * 2048 + k * 1024); } while (0)
#define PG8_LDB(dst, b, h) do { _Pragma("unroll") for (int n = 0; n < 2; ++n) _Pragma("unroll") for (int k = 0; k < 2; ++k) dst[n][k] = *(const PG8_LAS bf16x8*)(lds + PG8_SB(b, h) + boff + n * 2048 + k * 1024); } while (0)
#define PG8_MMA(ai, bj, At, Bt) do { __builtin_amdgcn_s_setprio(1); _Pragma("unroll") for (int m = 0; m < 4; ++m) _Pragma("unroll") for (int n = 0; n < 2; ++n) _Pragma("unroll") for (int k = 0; k < 2; ++k) \
        acc[ai][bj][m][n] = __builtin_amdgcn_mfma_f32_16x16x32_bf16(Bt[n][k], At[m][k], acc[ai][bj][m][n], 0, 0, 0); __builtin_amdgcn_s_setprio(0); } while (0)
#define PG8_WAIT_V(n) asm volatile("s_waitcnt vmcnt(" #n ")" ::: "memory")
#define PG8_WAIT_L(n) asm volatile("s_waitcnt lgkmcnt(" #n ")" ::: "memory")
#define PG8_BAR __builtin_amdgcn_s_barrier()
#define PG8_SCHED __builtin_amdgcn_sched_barrier(0)
    Unit cur, nxt; int ui = 0;
    if (!S.next(0, cur)) return;
    f32x4 acc[2][2][4][2];
#pragma unroll
    for (int a = 0; a < 2; ++a)
#pragma unroll
        for (int b = 0; b < 2; ++b)
#pragma unroll
            for (int m = 0; m < 4; ++m)
#pragma unroll
                for (int n = 0; n < 2; ++n) acc[a][b][m][n] = (f32x4){0.f, 0.f, 0.f, 0.f};
    bf16x8 At[4][2], B0[2][2], B1[2][2];
    const char* cA = cur.a; const char* cB = cur.b;
    PG8_STAGE(PG8_SB(0, 0), cB, voffB); PG8_STAGE(PG8_SB(0, 1), cB + hstepB, voffB); PG8_STAGE(PG8_SA(0, 0), cA, voffA); PG8_STAGE(PG8_SA(0, 1), cA + hstepA, voffA);
    if (wr == 1) PG8_BAR;
    PG8_WAIT_V(2); PG8_BAR;
    PG8_STAGE(PG8_SB(1, 0), cB + kstep, voffB); PG8_STAGE(PG8_SA(1, 0), cA + kstep, voffA); PG8_STAGE(PG8_SB(1, 1), cB + hstepB + kstep, voffB);
    PG8_WAIT_V(6); PG8_BAR;
    for (;;) {
        const bool has_next = S.next(ui + 1, nxt);
        const char* nA = has_next ? nxt.a : cA; const char* nB = has_next ? nxt.b : cB;
        for (int t = 0; t < nt; t += 2) {
            const bool last = (t == nt - 2);
            const char* a1 = cA + (size_t)(t + 1) * kstep;
            const char* a2 = last ? nA : cA + (size_t)(t + 2) * kstep; const char* b2 = last ? nB : cB + (size_t)(t + 2) * kstep;
            const char* a3 = a2 + kstep; const char* b3 = b2 + kstep;
            PG8_LDB(B0, 0, 0); PG8_LDB(B1, 0, 1); PG8_SCHED; PG8_LDA(At, 0, 0); PG8_STAGE(PG8_SA(1, 1), a1 + hstepA, voffA);
            PG8_WAIT_V(8); PG8_WAIT_L(0); PG8_BAR; PG8_MMA(0, 0, At, B0); PG8_MMA(0, 1, At, B1); PG8_BAR; PG8_SCHED;
            PG8_LDA(At, 0, 1); PG8_STAGE(PG8_SB(0, 0), b2, voffB); PG8_STAGE(PG8_SB(0, 1), b2 + hstepB, voffB); PG8_STAGE(PG8_SA(0, 0), a2, voffA);
            PG8_WAIT_V(8); PG8_WAIT_L(0); PG8_BAR; PG8_MMA(1, 0, At, B0); PG8_MMA(1, 1, At, B1); PG8_BAR; PG8_SCHED;
            PG8_LDB(B0, 1, 0); PG8_LDB(B1, 1, 1); PG8_SCHED; PG8_LDA(At, 1, 0); PG8_STAGE(PG8_SA(0, 1), a2 + hstepA, voffA);
            PG8_WAIT_V(8); PG8_WAIT_L(0); PG8_BAR; PG8_MMA(0, 0, At, B0); PG8_MMA(0, 1, At, B1); PG8_BAR; PG8_SCHED;
            PG8_LDA(At, 1, 1); PG8_STAGE(PG8_SB(1, 0), b3, voffB); PG8_STAGE(PG8_SB(1, 1), b3 + hstepB, voffB); PG8_STAGE(PG8_SA(1, 0), a3, voffA);
            PG8_WAIT_V(8); PG8_WAIT_L(0); PG8_BAR; PG8_MMA(1, 0, At, B0); PG8_MMA(1, 1, At, B1); PG8_BAR; PG8_SCHED;
        }
        if (wr == 0) PG8_BAR;
        E(acc, cur, wr, wc, fr, fq);
        if (!has_next) break;
#pragma unroll
        for (int a = 0; a < 2; ++a)
#pragma unroll
            for (int b = 0; b < 2; ++b)
#pragma unroll
                for (int m = 0; m < 4; ++m)
#pragma unroll
                    for (int n = 0; n < 2; ++n) acc[a][b][m][n] = (f32x4){0.f, 0.f, 0.f, 0.f};
        cur = nxt; cA = nA; cB = nB; ++ui;
        if (wr == 1) PG8_BAR;
    }
    PG8_WAIT_V(0);
    PG8_BAR;
#undef PG8_SA
#undef PG8_SB
#undef PG8_STAGE
#undef PG8_LDA
#undef PG8_LDB
#undef PG8_MMA
#undef PG8_WAIT_V
#undef PG8_WAIT_L
#undef PG8_BAR
#undef PG8_SCHED
}
}

template <class Dest>
__device__ __forceinline__ void transpose_item(const float* W, int K, int N, bf16* WT, int ldk, const Dest& dest, LAS float* scr, int item, int lane) {
    const int nblk = N / 32, kb = item / nblk, nb = item % nblk, k0 = 64 * kb, n0 = 32 * nb;
#pragma unroll 8
    for (int i = 0; i < 32; ++i) { const int kk = 2 * i + (lane >> 5); scr[kk * 33 + (lane & 31)] = W[(size_t)(k0 + kk) * N + n0 + (lane & 31)]; }
    asm volatile("s_waitcnt lgkmcnt(0)" ::: "memory");
    const int c = lane & 7;
#pragma unroll
    for (int j = 0; j < 4; ++j) { const int n = (lane >> 3) + 8 * j; const LAS float* sp = scr + (8 * c) * 33 + n;
        u32x4 o; o.x = pk2(sp[0 * 33], sp[1 * 33]); o.y = pk2(sp[2 * 33], sp[3 * 33]); o.z = pk2(sp[4 * 33], sp[5 * 33]); o.w = pk2(sp[6 * 33], sp[7 * 33]);
        const int dr = dest(n0 + n);
        if (dr >= 0) *(u32x4*)(WT + (size_t)dr * ldk + k0 + 8 * c) = o; }
    asm volatile("s_waitcnt lgkmcnt(0)" ::: "memory");
}
struct DestId { int off; __device__ __forceinline__ int operator()(int n) const { return off + n; } };
struct DestGU { int up; __device__ __forceinline__ int operator()(int n) const { return (n >> 7) * 256 + up * 128 + (n & 127); } };


namespace fa {
using bf16x8 = __attribute__((ext_vector_type(8))) short;
using s16x4  = __attribute__((ext_vector_type(4))) short;
using f32x16 = __attribute__((ext_vector_type(16))) float;
constexpr int SHM_V = 64 * 64 * 2, SHM_K = 64 * 256, LDS_V = 0, LDS_K = 2 * SHM_V, LDS_WS = LDS_K + 2 * SHM_K;
constexpr int NT = 129;
constexpr float THRL = 8.0f;
#define FA_KSWZ(row, colB) ((row) * 256 + ((colB) ^ (((row) & 7) << 4)))
#define FA_SBAR() __builtin_amdgcn_sched_barrier(0)
__device__ __forceinline__ int crow(int r, int hi) { return (r & 3) + 8 * (r >> 2) + 4 * hi; }
__device__ __forceinline__ unsigned cvtpk(float lo, float hi) { unsigned r; asm volatile("v_cvt_pk_bf16_f32 %0, %1, %2" : "=v"(r) : "v"(lo), "v"(hi)); return r; }
__device__ __forceinline__ void partialSM(f32x16& p0, f32x16& p1, float& m_reg, float& alpha) {
    float pmax = p0[0];
#pragma unroll
    for (int r = 1; r < 16; ++r) pmax = fmaxf(pmax, p0[r]);
#pragma unroll
    for (int r = 0; r < 16; ++r) pmax = fmaxf(pmax, p1[r]);
    { auto rr = __builtin_amdgcn_permlane32_swap(__float_as_uint(pmax), __float_as_uint(pmax), false, false); pmax = fmaxf(__uint_as_float(rr[0]), __uint_as_float(rr[1])); }
    float mn;
    if (__builtin_expect(__all(pmax - m_reg <= THRL), 1)) { mn = m_reg; alpha = 1.f; }
    else { mn = fmaxf(m_reg, pmax); alpha = __builtin_amdgcn_exp2f(m_reg - mn); m_reg = mn; }
#pragma unroll
    for (int r = 0; r < 16; ++r) p0[r] -= mn;
#pragma unroll
    for (int r = 0; r < 16; ++r) p1[r] -= mn;
#pragma unroll
    for (int r = 0; r < 16; ++r) p0[r] = __builtin_amdgcn_exp2f(p0[r]);
}
__device__ __forceinline__ void finishSM(f32x16& p0, f32x16& p1, float alpha, float& l_reg, bf16x8& pa0, bf16x8& pa1, bf16x8& pa2, bf16x8& pa3) {
#pragma unroll
    for (int r = 0; r < 16; ++r) p1[r] = __builtin_amdgcn_exp2f(p1[r]);
    float ps = 0;
#pragma unroll
    for (int r = 0; r < 16; ++r) ps += p0[r];
#pragma unroll
    for (int r = 0; r < 16; ++r) ps += p1[r];
    { auto rr = __builtin_amdgcn_permlane32_swap(__float_as_uint(ps), __float_as_uint(ps), false, false); ps = __uint_as_float(rr[0]) + __uint_as_float(rr[1]); }
    l_reg = l_reg * alpha + ps;
#define FA_PK4(P, BASE, OUT) do { unsigned a0 = cvtpk(P[BASE + 0], P[BASE + 1]), a1 = cvtpk(P[BASE + 2], P[BASE + 3]);   \
    unsigned b0 = cvtpk(P[BASE + 4], P[BASE + 5]), b1 = cvtpk(P[BASE + 6], P[BASE + 7]);                              \
    auto r0 = __builtin_amdgcn_permlane32_swap(a0, b0, false, false); auto r1 = __builtin_amdgcn_permlane32_swap(a1, b1, false, false); \
    u32x4 w = {r0[0], r1[0], r0[1], r1[1]}; OUT = __builtin_bit_cast(bf16x8, w); } while (0)
    FA_PK4(p0, 0, pa0); FA_PK4(p0, 8, pa1); FA_PK4(p1, 0, pa2); FA_PK4(p1, 8, pa3);
#undef FA_PK4
}
__device__ __forceinline__ void qkt(f32x16& p0, f32x16& p1, const LAS unsigned char* Ks, const bf16x8* qr, int r32, int hi) {
    p0 = f32x16{}; p1 = f32x16{};
#pragma unroll
    for (int d0 = 0; d0 < 6; ++d0) { const int cb = (d0 * 16 + hi * 8) * 2;
        const bf16x8 b0 = *(const LAS bf16x8*)(Ks + FA_KSWZ(r32, cb));
        const bf16x8 b1 = *(const LAS bf16x8*)(Ks + FA_KSWZ(32 + r32, cb));
        p0 = __builtin_amdgcn_mfma_f32_32x32x16_bf16(b0, qr[d0], p0, 0, 0, 0);
        p1 = __builtin_amdgcn_mfma_f32_32x32x16_bf16(b1, qr[d0], p1, 0, 0, 0); }
}
__device__ __forceinline__ int v_st(int k, int c) { const int kk = (k & ~0xC) | ((k & 4) << 1) | ((k & 8) >> 1); return ((kk >> 3) * 2 + (c >> 5)) * 512 + ((kk & 7) * 32 + (c & 31)) * 2; }
__device__ __forceinline__ int v_rd_base(int lane) { return ((lane & 3) << 3) | (((lane >> 2) & 3) << 6) | (((lane >> 4) & 1) << 5) | (((lane >> 5) & 1) << 8); }
constexpr int v_rd_off(int d0, int ks, int half) { return d0 * 512 + ks * 2048 + half * 1024; }
template <int OFF> __device__ __forceinline__ s16x4 tr_read(int vb) { s16x4 r; asm volatile("ds_read_b64_tr_b16 %0, %1 offset:%2" : "=&v"(r) : "v"(vb), "i"(OFF) : "memory"); return r; }
template <int D0> __device__ __forceinline__ void pv_one(f32x16& od, int vb, bf16x8 pa0, bf16x8 pa1, bf16x8 pa2, bf16x8 pa3) {
    const s16x4 l0 = tr_read<v_rd_off(D0, 0, 0)>(vb), h0 = tr_read<v_rd_off(D0, 0, 1)>(vb), l1 = tr_read<v_rd_off(D0, 1, 0)>(vb), h1 = tr_read<v_rd_off(D0, 1, 1)>(vb);
    const s16x4 l2 = tr_read<v_rd_off(D0, 2, 0)>(vb), h2 = tr_read<v_rd_off(D0, 2, 1)>(vb), l3 = tr_read<v_rd_off(D0, 3, 0)>(vb), h3 = tr_read<v_rd_off(D0, 3, 1)>(vb);
    asm volatile("s_waitcnt lgkmcnt(0)" ::: "memory"); FA_SBAR();
#define FA_PK(L, H) (bf16x8){L[0], L[1], L[2], L[3], H[0], H[1], H[2], H[3]}
    od = __builtin_amdgcn_mfma_f32_32x32x16_bf16(pa0, FA_PK(l0, h0), od, 0, 0, 0);
    od = __builtin_amdgcn_mfma_f32_32x32x16_bf16(pa1, FA_PK(l1, h1), od, 0, 0, 0);
    od = __builtin_amdgcn_mfma_f32_32x32x16_bf16(pa2, FA_PK(l2, h2), od, 0, 0, 0);
    od = __builtin_amdgcn_mfma_f32_32x32x16_bf16(pa3, FA_PK(l3, h3), od, 0, 0, 0);
#undef FA_PK
}
__device__ __forceinline__ void pv_d0(f32x16* o, int vb, bf16x8 pa0, bf16x8 pa1, bf16x8 pa2, bf16x8 pa3) { pv_one<0>(o[0], vb, pa0, pa1, pa2, pa3); pv_one<1>(o[1], vb, pa0, pa1, pa2, pa3); }

__device__ __forceinline__ void attn_unit(int b, int h, int xr0, const bf16* __restrict__ Q, const bf16* __restrict__ KB, const bf16* __restrict__ VB, bf16* __restrict__ AO, LAS unsigned char* lds) {
    const int tid = threadIdx.x, wid = tid >> 6, lane = tid & 63, r32 = lane & 31, hi = lane >> 5;
    LAS unsigned char* V_lds = lds + LDS_V; LAS unsigned char* K_lds = lds + LDS_K;
    LAS float* ws = (LAS float*)(lds + LDS_WS) + wid * 64; LAS float* li_l = ws; LAS float* al_l = ws + 32;
    float m_reg = -1e30f, l_reg = 0; f32x16 o[2] = {}; bf16x8 qr[6];
    const bf16* Qw = Q + (size_t)(xr0 + wid * 32 + r32) * 768 + h * 96 + hi * 8;
#pragma unroll
    for (int d0 = 0; d0 < 6; ++d0) qr[d0] = *(const bf16x8*)(Qw + d0 * 16);
    const int srow = tid >> 3, sch = tid & 7, srow2 = (tid >> 2) & 63, sch2 = 8 + (tid & 3); const bool has2 = tid < 256;
    const int vst = v_st(srow, sch * 8), kst1 = FA_KSWZ(srow, sch * 16), kst2 = FA_KSWZ(srow2, sch2 * 16);
    const int vb0 = (int)(uintptr_t)V_lds + v_rd_base(lane);
    const bf16* Kh = KB + h * 96; const bf16* Vh = VB + h * 64;
    bf16x8 sv[2], sk1[2], sk2[2];
#define FA_KROW(t) ((t) < 128 ? (size_t)b * SEQ + (size_t)(t) * 64 : (size_t)META_ROW0)
#define FA_SLOAD(i, t) do { const size_t kr_ = FA_KROW(t); sv[i] = *(const bf16x8*)(Vh + (kr_ + srow) * 512 + sch * 8); sk1[i] = *(const bf16x8*)(Kh + (kr_ + srow) * 768 + sch * 8); \
        if (has2) sk2[i] = *(const bf16x8*)(Kh + (kr_ + srow2) * 768 + sch2 * 8); } while (0)
#define FA_SWRITE(bufi, i) do { *(LAS bf16x8*)(V_lds + (bufi) * SHM_V + vst) = sv[i]; *(LAS bf16x8*)(K_lds + (bufi) * SHM_K + kst1) = sk1[i]; if (has2) *(LAS bf16x8*)(K_lds + (bufi) * SHM_K + kst2) = sk2[i]; } while (0)
#define FA_RESC(a) do { if (__any((a) < 1.f)) { if (hi == 0) al_l[r32] = (a); asm volatile("s_waitcnt lgkmcnt(0)" ::: "memory"); \
        _Pragma("unroll") for (int d = 0; d < 2; ++d) _Pragma("unroll") for (int r = 0; r < 16; ++r) o[d][r] *= al_l[crow(r, hi)]; } } while (0)
    f32x16 pA0, pA1, pB0, pB1; float alA, alB; bf16x8 pa0, pa1, pa2, pa3;
    FA_SLOAD(0, 0); FA_SWRITE(0, 0); __syncthreads();
    qkt(pA0, pA1, K_lds, qr, r32, hi); partialSM(pA0, pA1, m_reg, alA);
    FA_SLOAD(1, 1); FA_SLOAD(0, 2);
    FA_SWRITE(1, 1); __syncthreads();
    for (int j = 1; j + 1 < NT; j += 2) {
        FA_SBAR(); qkt(pB0, pB1, K_lds + SHM_K, qr, r32, hi);
        finishSM(pA0, pA1, alA, l_reg, pa0, pa1, pa2, pa3); FA_SBAR();
        if (j + 2 < NT) FA_SLOAD(1, j + 2); FA_SBAR();
        pv_d0(o, vb0, pa0, pa1, pa2, pa3); partialSM(pB0, pB1, m_reg, alB);
        __syncthreads(); FA_SWRITE(0, 0);
        FA_RESC(alB); __syncthreads();
        FA_SBAR(); qkt(pA0, pA1, K_lds, qr, r32, hi);
        finishSM(pB0, pB1, alB, l_reg, pa0, pa1, pa2, pa3); FA_SBAR();
        if (j + 3 < NT) FA_SLOAD(0, j + 3); FA_SBAR();
        if (j + 1 == NT - 1) {
#pragma unroll
            for (int r = 8; r < 16; ++r) pA0[r] = -1e30f;
#pragma unroll
            for (int r = 0; r < 16; ++r) pA1[r] = -1e30f;
        }
        pv_d0(o, vb0 + SHM_V, pa0, pa1, pa2, pa3); partialSM(pA0, pA1, m_reg, alA);
        __syncthreads(); if (j + 2 < NT) FA_SWRITE(1, 1);
        FA_RESC(alA); __syncthreads();
    }
    finishSM(pA0, pA1, alA, l_reg, pa0, pa1, pa2, pa3); FA_SBAR();
    pv_d0(o, vb0, pa0, pa1, pa2, pa3);
    if (hi == 0) li_l[r32] = l_reg; asm volatile("s_waitcnt lgkmcnt(0)" ::: "memory");
    float rli[16];
#pragma unroll
    for (int r = 0; r < 16; ++r) rli[r] = __builtin_amdgcn_rcpf(li_l[crow(r, hi)]);
    bf16* Ow = AO + (size_t)(xr0 + wid * 32) * 1024 + h * 64;
#pragma unroll
    for (int r = 0; r < 16; ++r) { const int orow = crow(r, hi);
#pragma unroll
        for (int d0 = 0; d0 < 2; ++d0) Ow[(size_t)orow * 1024 + d0 * 32 + r32] = (bf16)f2bf(o[d0][r] * rli[r]); }
    __syncthreads();
#undef FA_KROW
#undef FA_SLOAD
#undef FA_SWRITE
#undef FA_RESC
}
}
__device__ __forceinline__ void ph_attn_f(Frame& F) {
    const bf16* Q = (const bf16*)(F.ws + WS_Q); const bf16* KB = (const bf16*)(F.ws + WS_KB); const bf16* VB = (const bf16*)(F.ws + WS_VB); bf16* AO = (bf16*)(F.ws + WS_AO);
    const int npx = F.G / 8;
    const int xg = F.vcu / npx, loc = F.vcu % npx;
    for (int i = 0; i < 4; ++i) {
        const int bh = xg * 4 + i;
        for (int qb = loc; qb < 32; qb += npx) fa::attn_unit(bh >> 3, bh & 7, (bh >> 3) * SEQ + qb * 256, Q, KB, VB, AO, (LAS unsigned char*)F.lds);
    }
}

__device__ __forceinline__ void rms_row_to_bf16(const float* xrow, const float* gain, bf16* orow, int lane) {
    const f32x4* xr = (const f32x4*)xrow + lane; f32x4 v[4]; float s = 0.f;
#pragma unroll
    for (int j = 0; j < 4; ++j) { v[j] = xr[64 * j]; s += (v[j].x * v[j].x + v[j].y * v[j].y) + (v[j].z * v[j].z + v[j].w * v[j].w); }
    const float rstd = 1.0f / sqrtf(wave_sum(s) * (1.f / DM) + EPS);
    unsigned long long* o8 = (unsigned long long*)orow + lane;
#pragma unroll
    for (int j = 0; j < 4; ++j) { const f32x4 g = ((const f32x4*)gain)[lane + 64 * j];
        o8[64 * j] = (unsigned long long)pk2(v[j].x * rstd * g.x, v[j].y * rstd * g.y) | ((unsigned long long)pk2(v[j].z * rstd * g.z, v[j].w * rstd * g.w) << 32); }
}

__device__ __forceinline__ void ph_prologue(Frame& F) {
    const int gw = F.vcu * NWAVES + F.wave, NGW = F.G * NWAVES;
    bf16* XN = (bf16*)(F.ws + WS_XN);
    for (int r = gw; r < MNAT; r += NGW) {
        const int b = r / LTOK, l = r % LTOK;
        const float* src = l < NMETA ? F.inp(IN_META) + (size_t)l * DM : F.inp(IN_X) + ((size_t)b * SEQ + (l - NMETA)) * DM;
        rms_row_to_bf16(src, F.inp(IN_G_PRE), XN + (size_t)r * DM, F.lane);
    }
    const int gt = F.vcu * NTHR + F.tid, NGT = F.G * NTHR;
    float2* rope = (float2*)(F.ws + WS_ROPE);
    for (int i = gt; i < LTOK * 16; i += NGT) {
        const int l = i >> 4, j = i & 15;
        const float ang = (float)l * INV_FREQ[j];
        const double rev = (double)ang * 0.15915494309189535; const float fr = (float)(rev - floor(rev));
        rope[i] = make_float2(hw_cos(fr), hw_sin(fr));
    }
    float2* tw = (float2*)(F.ws + WS_TW);
    for (int i = gt; i < LTOK; i += NGT) { const float fr = (float)i / (float)LTOK; tw[i] = make_float2(hw_cos(fr), hw_sin(fr)); }
    float* WU = (float*)(F.ws + WS_WU);
    const float norm = 1.0f / sqrtf((float)LTOK * (float)FGD);
    for (int i = gt; i < 4 * 128 * 2 * 128; i += NGT) {
        const int d = i & 127, p = (i >> 7) & 1, c = (i >> 8) & 127, g = i >> 15;
        const float* wf = F.inp(IN_W_FOUR) + (size_t)g * 128 * 128 + d;
        float acc = 0.f;
        for (int j = 0; j < 128; ++j) { const float fr = (float)((c * j) & 127) * (1.0f / 128.0f); acc += (p ? -hw_sin(fr) : hw_cos(fr)) * wf[(size_t)j * 128]; }
        WU[i] = acc * norm;
    }
    {
        LAS float* scr = (LAS float*)((LAS unsigned char*)F.lds + F.wave * 16384);
        constexpr int I_O = (DM / 64) * (DM / 32), I_G = (DM / 64) * (DFF / 32), I_D = (DFF / 64) * (DM / 32);
        const float* w_o = F.inp(IN_W_O); const float* w_g = F.inp(IN_W_GATE); const float* w_u = F.inp(IN_W_UP); const float* w_d = F.inp(IN_W_DOWN);
        for (int it = gw; it < I_O + 2 * I_G + I_D; it += NGW) {
            int r = it;
            if (r < I_O) { transpose_item(w_o, DM, DM, (bf16*)(F.ws + WS_WO), DM, DestId{0}, scr, r, F.lane); continue; } r -= I_O;
            if (r < I_G) { transpose_item(w_g, DM, DFF, (bf16*)(F.ws + WS_WGU), DM, DestGU{0}, scr, r, F.lane); continue; } r -= I_G;
            if (r < I_G) { transpose_item(w_u, DM, DFF, (bf16*)(F.ws + WS_WGU), DM, DestGU{1}, scr, r, F.lane); continue; } r -= I_G;
            transpose_item(w_d, DFF, DM, (bf16*)(F.ws + WS_WDN), DFF, DestId{0}, scr, r, F.lane);
        }
    }
    bf16* KB = (bf16*)(F.ws + WS_KB); bf16* VB = (bf16*)(F.ws + WS_VB);
    for (int i = gt; i < 48 * 768; i += NGT) KB[(size_t)(META_ROW0 + 16) * 768 + i] = 0;
    for (int i = gt; i < 48 * 512; i += NGT) VB[(size_t)(META_ROW0 + 16) * 512 + i] = 0;
}

template <typename TA> __device__ __forceinline__ void sg_load_a4(const TA* p, float (&o)[4]);
template <> __device__ __forceinline__ void sg_load_a4<bf16>(const bf16* p, float (&o)[4]) { const u32x2 w = *(const u32x2*)p; o[0] = bf2f(w.x & 0xffffu); o[1] = bf2f(w.x >> 16); o[2] = bf2f(w.y & 0xffffu); o[3] = bf2f(w.y >> 16); }
template <> __device__ __forceinline__ void sg_load_a4<float>(const float* p, float (&o)[4]) { const f32x4 w = *(const f32x4*)p; o[0] = w.x; o[1] = w.y; o[2] = w.z; o[3] = w.w; }

template <bool DUAL, typename TA, class Epi>
__device__ __forceinline__ void sgemm(Frame& F, const TA* A, int lda, int M, const float* W0, const float* W1, int ldw, int N, int K, const Epi& epi) {
    float* As = (float*)F.lds;
    float* Bs0 = As + 16 * 132;
    const int tid = F.tid, tx = tid & 31, ty = tid >> 5;
    const int NT = DUAL ? 64 : 128;
    const int nMt = (M + 127) / 128, nNt = (N + NT - 1) / NT, items = nMt * nNt;
    for (int item = blockIdx.x; item < items; item += F.G) {
        const int m0 = (item / nNt) * 128, n0 = (item % nNt) * NT;
        float acc0[8][4];
#pragma unroll
        for (int i = 0; i < 8; ++i)
#pragma unroll
            for (int j = 0; j < 4; ++j) acc0[i][j] = 0.f;
        const int ar = tid >> 2, akq = (tid & 3) * 4, bk = tid >> 5, bt = tid & 31;
        const int bcol = DUAL ? n0 + (bt & 15) * 4 : n0 + bt * 4;
        const float* Wb = (DUAL && bt >= 16) ? W1 : W0;
        for (int k0 = 0; k0 < K; k0 += 16) {
            float av[4] = {0.f, 0.f, 0.f, 0.f};
            if (m0 + ar < M) sg_load_a4<TA>(A + (size_t)(m0 + ar) * lda + k0 + akq, av);
            f32x4 b0 = {0.f, 0.f, 0.f, 0.f};
            if (bcol < N) b0 = *(const f32x4*)(Wb + (size_t)(k0 + bk) * ldw + bcol);
            __syncthreads();
#pragma unroll
            for (int i = 0; i < 4; ++i) As[(akq + i) * 132 + ar] = av[i];
            *(f32x4*)(Bs0 + bk * 128 + bt * 4) = b0;
            __syncthreads();
#pragma unroll
            for (int kk = 0; kk < 16; ++kk) {
                const f32x4 a0 = *(const f32x4*)(As + kk * 132 + ty * 8), a1 = *(const f32x4*)(As + kk * 132 + ty * 8 + 4);
                const f32x4 bb0 = *(const f32x4*)(Bs0 + kk * 128 + tx * 4);
                const float a[8] = {a0.x, a0.y, a0.z, a0.w, a1.x, a1.y, a1.z, a1.w};
#pragma unroll
                for (int i = 0; i < 8; ++i) { acc0[i][0] += a[i] * bb0.x; acc0[i][1] += a[i] * bb0.y; acc0[i][2] += a[i] * bb0.z; acc0[i][3] += a[i] * bb0.w; }
            }
        }
        const int ecol = DUAL ? n0 + (tx & 15) * 4 : n0 + tx * 4;
#pragma unroll
        for (int i = 0; i < 8; ++i) {
            float other[4] = {0.f, 0.f, 0.f, 0.f};
            if (DUAL) {
#pragma unroll
                for (int j = 0; j < 4; ++j) other[j] = __shfl_xor(acc0[i][j], 16);
            }
            const int row = m0 + ty * 8 + i;
            if (row < M && ecol < N && (!DUAL || tx < 16)) epi(row, ecol, acc0[i], other);
        }
    }
    __syncthreads();
}
struct EpiStoreF32 { float* C; int ldc;
    __device__ __forceinline__ void operator()(int row, int col, const float (&v)[4], const float (&)[4]) const { *(f32x4*)(C + (size_t)row * ldc + col) = (f32x4){v[0], v[1], v[2], v[3]}; } };
struct EpiX0 { bf16* X0; int g;
    __device__ __forceinline__ void operator()(int row, int col, const float (&v)[4], const float (&)[4]) const {
        const int b = row / LTOK, l = row % LTOK, l1 = l / FN2, l2 = l % FN2;
#pragma unroll
        for (int i = 0; i < 4; ++i) { const int c = col + i, p = c >> 7, d = c & 127, cc = g * 128 + d;
            X0[((((size_t)b * 512 + cc) * FN2 + l2) * 2 + p) * 128 + l1] = (bf16)f2bf(v[i]); }
    } };
struct EpiSwiglu { bf16* ACT;
    __device__ __forceinline__ void operator()(int row, int col, const float (&g)[4], const float (&u)[4]) const {
        float o[4];
#pragma unroll
        for (int i = 0; i < 4; ++i) o[i] = g[i] / (1.0f + __expf(-g[i])) * u[i];
        *(u32x2*)(ACT + (size_t)row * DFF + col) = (u32x2){pk2(o[0], o[1]), pk2(o[2], o[3])};
    } };

__device__ __forceinline__ void ph_norms_s(Frame& F) {
    const int gw = F.vcu * NWAVES + F.wave, NGW = F.G * NWAVES, lane = F.lane;
    const float* Z = (const float*)(F.ws + WS_Z); bf16* ZQ = (bf16*)(F.ws + WS_ZQ); bf16* ZKV = (bf16*)(F.ws + WS_ZKV);
    const float2* rope = (const float2*)(F.ws + WS_ROPE);
    for (int r = gw; r < MNAT; r += NGW) {
        const int b = r / LTOK, l = r % LTOK; const float* z = Z + (size_t)r * INW;
        if (l >= NMETA) {
            const int xr = b * SEQ + l - NMETA;
            const f32x4 v = *(const f32x4*)(z + lane * 4);
            const float ss = wave_sum((v.x * v.x + v.y * v.y) + (v.z * v.z + v.w * v.w));
            const float rstd = 1.0f / sqrtf(ss * (1.f / QLR) + EPS);
            const f32x4 g = *(const f32x4*)(F.inp(IN_G_QA) + lane * 4);
            *(u32x2*)(ZQ + (size_t)xr * 256 + lane * 4) = (u32x2){pk2(v.x * rstd * g.x, v.y * rstd * g.y), pk2(v.z * rstd * g.z, v.w * rstd * g.w)};
        }
        const int kvrow = l >= NMETA ? b * SEQ + l - NMETA : (b == 0 ? META_ROW0 + l : -1);
        {
            const float v0 = z[256 + lane * 2], v1 = z[256 + lane * 2 + 1];
            const float ss = wave_sum(v0 * v0 + v1 * v1);
            const float rstd = 1.0f / sqrtf(ss * (1.f / KVLR) + EPS);
            if (kvrow >= 0) {
                bf16* o = ZKV + (size_t)kvrow * 256;
                *(unsigned*)(o + lane * 2) = pk2(v0 * rstd * F.inp(IN_G_KVA)[lane * 2], v1 * rstd * F.inp(IN_G_KVA)[lane * 2 + 1]);
                if (lane < 16) { const float x1 = z[384 + lane], x2 = z[400 + lane]; const float2 cs = rope[l * 16 + lane];
                    o[128 + lane] = (bf16)f2bf(x1 * cs.x - x2 * cs.y); o[144 + lane] = (bf16)f2bf(x2 * cs.x + x1 * cs.y); }
                o[160 + lane] = 0; if (lane < 32) o[224 + lane] = 0;
            }
        }
    }
}
__device__ __forceinline__ void ph_qpost_s(Frame& F) {
    const int gw = F.vcu * NWAVES + F.wave, NGW = F.G * NWAVES, lane = F.lane;
    const float* Y = (const float*)(F.ws + WS_YQ); bf16* Q = (bf16*)(F.ws + WS_Q); const float2* rope = (const float2*)(F.ws + WS_ROPE);
    for (int r = gw; r < MX; r += NGW) {
        const int l = (r % SEQ) + NMETA; const float* y = Y + (size_t)r * 768;
        for (int i = 0; i < 12; ++i) { const int col = lane + 64 * i, d = col % 96; float o;
            if (d < 64) o = y[col];
            else { const int j = d - 64; if (j < 16) { const float2 cs = rope[l * 16 + j]; o = y[col] * cs.x - y[col + 16] * cs.y; }
                   else { const float2 cs = rope[l * 16 + j - 16]; o = y[col] * cs.x + y[col - 16] * cs.y; } }
            Q[(size_t)r * 768 + col] = (bf16)f2bf(o * C2); }
    }
}
__device__ __forceinline__ void ph_kvpost_s(Frame& F) {
    const int gw = F.vcu * NWAVES + F.wave, NGW = F.G * NWAVES, lane = F.lane;
    const float* Y = (const float*)(F.ws + WS_YQ); bf16* KB = (bf16*)(F.ws + WS_KB); bf16* VB = (bf16*)(F.ws + WS_VB); const bf16* ZKV = (const bf16*)(F.ws + WS_ZKV);
    for (int r = gw; r < META_ROW0 + NMETA; r += NGW) {
        const float* y = Y + (size_t)r * 1024;
        for (int i = 0; i < 16; ++i) { const int col = lane + 64 * i, h = col >> 7, d = col & 127;
            if (d < 64) KB[(size_t)r * 768 + h * 96 + d] = (bf16)f2bf(y[col]); else VB[(size_t)r * 512 + h * 64 + d - 64] = (bf16)f2bf(y[col]); }
        for (int i = 0; i < 4; ++i) { const int idx = lane + 64 * i, h = idx >> 5, j = idx & 31; KB[(size_t)r * 768 + h * 96 + 64 + j] = ZKV[(size_t)r * 256 + 128 + j]; }
    }
}
__device__ __forceinline__ void ph_s1_s(Frame& F) {
    const int gw = F.vcu * NWAVES + F.wave, NGW = F.G * NWAVES, lane = F.lane;
    float* tab = (float*)F.lds;
    float* us = (float*)F.lds + 256 + F.wave * 256;
    for (int i = F.tid; i < FN1; i += NTHR) { const float fr = (float)i / (float)FN1; tab[i] = hw_cos(fr); tab[128 + i] = hw_sin(fr); }
    __syncthreads();
    const bf16* X0 = (const bf16*)(F.ws + WS_X0); bf16* X1 = (bf16*)(F.ws + WS_X1); const float2* tw = (const float2*)(F.ws + WS_TW);
    for (int it = gw; it < NB * 512 * FN2; it += NGW) {
        const int l2 = it % FN2, cc = (it / FN2) % 512, b = it / (FN2 * 512);
        const bf16* src = X0 + (size_t)it * 256;
        { const u32x2 w = *(const u32x2*)(src + lane * 4); us[lane * 4] = bf2f(w.x & 0xffffu); us[lane * 4 + 1] = bf2f(w.x >> 16); us[lane * 4 + 2] = bf2f(w.y & 0xffffu); us[lane * 4 + 3] = bf2f(w.y >> 16); }
        __builtin_amdgcn_wave_barrier(); asm volatile("s_waitcnt lgkmcnt(0)" ::: "memory");
        for (int k1 = lane; k1 < FN1; k1 += 64) {
            float ar = 0.f, ai = 0.f; int m = 0;
            for (int l1 = 0; l1 < FN1; ++l1) { const float c = tab[m], s = tab[128 + m], ur = us[l1], ui = us[128 + l1];
                ar += ur * c + ui * s; ai += ui * c - ur * s; m += k1; if (m >= FN1) m -= FN1; }
            const float2 t = tw[l2 * k1];
            const float br = ar * t.x + ai * t.y, bi = ai * t.x - ar * t.y;
            bf16* dst = X1 + ((((size_t)b * FN1 + k1) * 512 + cc) * 2) * 128 + l2;
            dst[0] = (bf16)f2bf(br); dst[128] = (bf16)f2bf(bi);
        }
        __builtin_amdgcn_wave_barrier(); asm volatile("s_waitcnt lgkmcnt(0)" ::: "memory");
    }
    __syncthreads();
}
__device__ __forceinline__ void ph_s2_s(Frame& F) {
    const int gw = F.vcu * NWAVES + F.wave, NGW = F.G * NWAVES, lane = F.lane;
    float* tab = (float*)F.lds; float* us = (float*)F.lds + 256 + F.wave * 256;
    for (int i = F.tid; i < FN2; i += NTHR) { const float fr = (float)i / (float)FN2; tab[i] = hw_cos(fr); tab[128 + i] = hw_sin(fr); }
    __syncthreads();
    const bf16* X1 = (const bf16*)(F.ws + WS_X1); bf16* AO = (bf16*)(F.ws + WS_AO);
    for (int it = gw; it < NB * FN1 * 512; it += NGW) {
        const int cc = it % 512, k1 = (it / 512) % FN1, b = it / (512 * FN1);
        const bf16* src = X1 + (size_t)it * 256;
        { const u32x2 w = *(const u32x2*)(src + lane * 4); us[lane * 4] = bf2f(w.x & 0xffffu); us[lane * 4 + 1] = bf2f(w.x >> 16); us[lane * 4 + 2] = bf2f(w.y & 0xffffu); us[lane * 4 + 3] = bf2f(w.y >> 16); }
        __builtin_amdgcn_wave_barrier(); asm volatile("s_waitcnt lgkmcnt(0)" ::: "memory");
        const float bias = F.inp(IN_B_FOUR)[cc];
        for (int k2 = lane; k2 < FN2; k2 += 64) {
            float y = 0.f; int m = 0;
            for (int l2 = 0; l2 < FN2; ++l2) { y += us[l2] * tab[m] + us[128 + l2] * tab[128 + m]; m += k2; if (m >= FN2) m -= FN2; }
            const int k = k1 + FN1 * k2;
            if (k >= NMETA) AO[((size_t)b * SEQ + k - NMETA) * 1024 + 512 + cc] = (bf16)f2bf(y + bias);
        }
        __builtin_amdgcn_wave_barrier(); asm volatile("s_waitcnt lgkmcnt(0)" ::: "memory");
    }
    __syncthreads();
}
__device__ __forceinline__ void ph_attn_s(Frame& F) {
    float* Ks = (float*)F.lds;
    float* Vs = Ks + 64 * 96;
    const bf16* Q = (const bf16*)(F.ws + WS_Q); const bf16* KB = (const bf16*)(F.ws + WS_KB); const bf16* VB = (const bf16*)(F.ws + WS_VB); bf16* AO = (bf16*)(F.ws + WS_AO);
    const int tid = F.tid, hf = tid & 1;
    for (int item = blockIdx.x; item < NB * NH * 32; item += F.G) {
        const int b = item >> 8, h = (item >> 5) & 7, qb = item & 31;
        const int xr = b * SEQ + qb * 256 + (tid >> 1);
        float q[48], o[32];
#pragma unroll
        for (int c = 0; c < 6; ++c) { const u32x4 w = *(const u32x4*)(Q + (size_t)xr * 768 + h * 96 + hf * 48 + c * 8);
            q[c * 8 + 0] = bf2f(w.x & 0xffffu); q[c * 8 + 1] = bf2f(w.x >> 16); q[c * 8 + 2] = bf2f(w.y & 0xffffu); q[c * 8 + 3] = bf2f(w.y >> 16);
            q[c * 8 + 4] = bf2f(w.z & 0xffffu); q[c * 8 + 5] = bf2f(w.z >> 16); q[c * 8 + 6] = bf2f(w.w & 0xffffu); q[c * 8 + 7] = bf2f(w.w >> 16); }
#pragma unroll
        for (int d = 0; d < 32; ++d) o[d] = 0.f;
        float m = -1e30f, l = 0.f;
        for (int tile = 0; tile < 129; ++tile) {
            const int nkeys = tile < 128 ? 64 : 16; const int krow0 = tile < 128 ? b * SEQ + tile * 64 : META_ROW0;
            __syncthreads();
            for (int c = tid; c < 768; c += NTHR) { const int row = c / 12, part = c % 12;
                if (row < nkeys) { const u32x4 w = *(const u32x4*)(KB + (size_t)(krow0 + row) * 768 + h * 96 + part * 8); float* dst = Ks + row * 96 + part * 8;
                    dst[0] = bf2f(w.x & 0xffffu); dst[1] = bf2f(w.x >> 16); dst[2] = bf2f(w.y & 0xffffu); dst[3] = bf2f(w.y >> 16);
                    dst[4] = bf2f(w.z & 0xffffu); dst[5] = bf2f(w.z >> 16); dst[6] = bf2f(w.w & 0xffffu); dst[7] = bf2f(w.w >> 16); } }
            { const int row = tid >> 3, part = tid & 7;
                if (row < nkeys) { const u32x4 w = *(const u32x4*)(VB + (size_t)(krow0 + row) * 512 + h * 64 + part * 8); float* dst = Vs + row * 64 + part * 8;
                    dst[0] = bf2f(w.x & 0xffffu); dst[1] = bf2f(w.x >> 16); dst[2] = bf2f(w.y & 0xffffu); dst[3] = bf2f(w.y >> 16);
                    dst[4] = bf2f(w.z & 0xffffu); dst[5] = bf2f(w.z >> 16); dst[6] = bf2f(w.w & 0xffffu); dst[7] = bf2f(w.w >> 16); } }
            __syncthreads();
            for (int j0 = 0; j0 < nkeys; j0 += 8) {
                float s[8];
#pragma unroll
                for (int jj = 0; jj < 8; ++jj) { const float* kr = Ks + (j0 + jj) * 96 + hf * 48; float a = 0.f;
#pragma unroll
                    for (int d = 0; d < 48; ++d) a += q[d] * kr[d];
                    s[jj] = a + __shfl_xor(a, 1); }
                float cm = s[0];
#pragma unroll
                for (int jj = 1; jj < 8; ++jj) cm = fmaxf(cm, s[jj]);
                const float mn = fmaxf(m, cm), alpha = exp2f(m - mn); m = mn; l *= alpha;
#pragma unroll
                for (int d = 0; d < 32; ++d) o[d] *= alpha;
#pragma unroll
                for (int jj = 0; jj < 8; ++jj) { const float p = exp2f(s[jj] - m); l += p; const float* vr = Vs + (j0 + jj) * 64 + hf * 32;
#pragma unroll
                    for (int d = 0; d < 32; ++d) o[d] += p * vr[d]; }
            }
        }
        const float rl = 1.0f / l;
#pragma unroll
        for (int c = 0; c < 4; ++c) { u32x4 w; w.x = pk2(o[c * 8] * rl, o[c * 8 + 1] * rl); w.y = pk2(o[c * 8 + 2] * rl, o[c * 8 + 3] * rl); w.z = pk2(o[c * 8 + 4] * rl, o[c * 8 + 5] * rl); w.w = pk2(o[c * 8 + 6] * rl, o[c * 8 + 7] * rl);
            *(u32x4*)(AO + (size_t)xr * 1024 + h * 64 + hf * 32 + c * 8) = w; }
    }
    __syncthreads();
}
__device__ __forceinline__ void ph_mrg_s(Frame& F) {
    const int gw = F.vcu * NWAVES + F.wave, NGW = F.G * NWAVES, lane = F.lane;
    const bf16* AO = (const bf16*)(F.ws + WS_AO); bf16* MRG = (bf16*)(F.ws + WS_MRG);
    for (int r = gw; r < MX; r += NGW) {
#pragma unroll
        for (int half = 0; half < 2; ++half) {
            const u32x4 w = *(const u32x4*)(AO + (size_t)r * 1024 + half * 512 + lane * 8);
            float v[8] = {bf2f(w.x & 0xffffu), bf2f(w.x >> 16), bf2f(w.y & 0xffffu), bf2f(w.y >> 16), bf2f(w.z & 0xffffu), bf2f(w.z >> 16), bf2f(w.w & 0xffffu), bf2f(w.w >> 16)};
            float ss = 0.f;
#pragma unroll
            for (int i = 0; i < 8; ++i) ss += v[i] * v[i];
            const float rstd = 1.0f / sqrtf(wave_sum(ss) * (1.f / 512.f) + EPS);
            const float* g = (half ? F.inp(IN_G_FOUR) : F.inp(IN_G_ATTN)) + lane * 8;
            u32x4 o; o.x = pk2(v[0] * rstd * g[0], v[1] * rstd * g[1]); o.y = pk2(v[2] * rstd * g[2], v[3] * rstd * g[3]); o.z = pk2(v[4] * rstd * g[4], v[5] * rstd * g[5]); o.w = pk2(v[6] * rstd * g[6], v[7] * rstd * g[7]);
            *(u32x4*)(MRG + (size_t)r * 1024 + half * 512 + lane * 8) = o;
        }
    }
}
__device__ __forceinline__ void ph_wopost_s(Frame& F) {
    const int gw = F.vcu * NWAVES + F.wave, NGW = F.G * NWAVES, lane = F.lane;
    const float* Y = (const float*)(F.ws + WS_Y3); bf16* XN2 = (bf16*)(F.ws + WS_XN);
    for (int r = gw; r < MX; r += NGW) {
        const f32x4* yr = (const f32x4*)(Y + (size_t)r * DM) + lane; const f32x4* xr = (const f32x4*)(F.inp(IN_X) + (size_t)r * DM) + lane;
        f32x4 v[4]; float s = 0.f;
#pragma unroll
        for (int j = 0; j < 4; ++j) { v[j] = yr[64 * j]; s += (v[j].x * v[j].x + v[j].y * v[j].y) + (v[j].z * v[j].z + v[j].w * v[j].w); }
        const float rstd = 1.0f / sqrtf(wave_sum(s) * (1.f / DM) + EPS);
        float s2 = 0.f;
#pragma unroll
        for (int j = 0; j < 4; ++j) { const f32x4 g = ((const f32x4*)F.inp(IN_G_POST))[lane + 64 * j]; v[j] = xr[64 * j] + v[j] * rstd * g;
            s2 += (v[j].x * v[j].x + v[j].y * v[j].y) + (v[j].z * v[j].z + v[j].w * v[j].w); ((f32x4*)(F.out + (size_t)r * DM))[lane + 64 * j] = v[j]; }
        const float rstd2 = 1.0f / sqrtf(wave_sum(s2) * (1.f / DM) + EPS);
        unsigned long long* o8 = (unsigned long long*)(XN2 + (size_t)r * DM) + lane;
#pragma unroll
        for (int j = 0; j < 4; ++j) { const f32x4 g = ((const f32x4*)F.inp(IN_G_PREFFN))[lane + 64 * j];
            o8[64 * j] = (unsigned long long)pk2(v[j].x * rstd2 * g.x, v[j].y * rstd2 * g.y) | ((unsigned long long)pk2(v[j].z * rstd2 * g.z, v[j].w * rstd2 * g.w) << 32); }
    }
}
__device__ __forceinline__ void ph_dnpost_s(Frame& F) {
    const int gw = F.vcu * NWAVES + F.wave, NGW = F.G * NWAVES, lane = F.lane;
    const float* Y = (const float*)(F.ws + WS_Y5);
    for (int r = gw; r < MX; r += NGW) {
        const f32x4* yr = (const f32x4*)(Y + (size_t)r * DM) + lane; f32x4* orow = (f32x4*)(F.out + (size_t)r * DM) + lane;
        f32x4 v[4]; float s = 0.f;
#pragma unroll
        for (int j = 0; j < 4; ++j) { v[j] = yr[64 * j]; s += (v[j].x * v[j].x + v[j].y * v[j].y) + (v[j].z * v[j].z + v[j].w * v[j].w); }
        const float rstd = 1.0f / sqrtf(wave_sum(s) * (1.f / DM) + EPS);
#pragma unroll
        for (int j = 0; j < 4; ++j) { const f32x4 g = ((const f32x4*)F.inp(IN_G_POSTFFN))[lane + 64 * j]; orow[64 * j] = orow[64 * j] + v[j] * rstd * g; }
    }
}

enum Phase { PH_PRO = 0, PH_INPROJ_S, PH_NORMS_S, PH_U_S, PH_Q_S, PH_QPOST_S, PH_KV_S, PH_KVPOST_S, PH_S1_S, PH_S2_S, PH_ATTN_S, PH_MRG_S, PH_WO_S, PH_WOPOST_S, PH_GU_S, PH_DN_S, PH_DNPOST_S, PH_COUNT };

struct Args { const float* in[19]; float* out; unsigned char* ws; int ph_lo, ph_hi, use_bar, pad; };

__global__ void __launch_bounds__(NTHR, 2) mega_fwd(Args args) {
    extern __shared__ __attribute__((aligned(16))) unsigned char lds[];
    Frame F;
    F.lds = lds; F.tid = threadIdx.x; F.lane = F.tid & 63; F.wave = __builtin_amdgcn_readfirstlane(F.tid >> 6);
    F.G = gridDim.x; { const int bx = blockIdx.x; F.vcu = (F.G % 8 == 0) ? (bx % 8) * (F.G / 8) + bx / 8 : bx; }
    F.out = args.out; F.ws = args.ws;
    volatile LAS unsigned* MISC = (volatile LAS unsigned*)((LAS unsigned char*)lds + MISC_OFF);
    for (int u = F.tid; u < (LDS_BYTES - LDSCTL_OFF) / 4; u += NTHR) ((LAS unsigned*)((LAS unsigned char*)lds + LDSCTL_OFF))[u] = 0u;
    if (F.tid < 19) { const unsigned long long p = (unsigned long long)args.in[F.tid]; LAS unsigned* t = (LAS unsigned*)((LAS unsigned char*)lds + PTR_OFF) + 2 * F.tid; t[0] = (unsigned)p; t[1] = (unsigned)(p >> 32); }
    __syncthreads();
    XcdBarrier bar; bar.bar = (unsigned*)(F.ws + WS_CTL) + CW_BAR; bar.x = 0; bar.st = nullptr;
    if (args.use_bar) bar = xcd_barrier_post((unsigned*)(F.ws + WS_CTL) + CW_BAR, MISC + 8);

    const int lo = args.ph_lo, hi = args.ph_hi;
    LAS unsigned char* ldsl = (LAS unsigned char*)lds;
#define PHASE(k, ...) do { if (lo <= (k) && (k) < hi) { __VA_ARGS__; if ((k) + 1 < hi) xcd_barrier(bar); } } while (0)
    PHASE(PH_PRO, ph_prologue(F));
    PHASE(PH_INPROJ_S, (sgemm<false, bf16>(F, (const bf16*)(F.ws + WS_XN), DM, MNAT, F.inp(IN_W_IN), nullptr, INW, INW, DM, EpiStoreF32{(float*)(F.ws + WS_Z), INW})));
    PHASE(PH_NORMS_S, ph_norms_s(F));
    PHASE(PH_U_S, { for (int g = 0; g < 4; ++g) sgemm<false, float>(F, (const float*)(F.ws + WS_Z) + 416 + g * 128, INW, MNAT, (const float*)(F.ws + WS_WU) + (size_t)g * 128 * 256, nullptr, 256, 256, 128, EpiX0{(bf16*)(F.ws + WS_X0), g}); });
    PHASE(PH_Q_S, (sgemm<false, bf16>(F, (const bf16*)(F.ws + WS_ZQ), 256, MX, F.inp(IN_W_QB), nullptr, 768, 768, 256, EpiStoreF32{(float*)(F.ws + WS_YQ), 768})));
    PHASE(PH_QPOST_S, ph_qpost_s(F));
    PHASE(PH_KV_S, (sgemm<false, bf16>(F, (const bf16*)(F.ws + WS_ZKV), 256, META_ROW0 + NMETA, F.inp(IN_W_KVB), nullptr, 1024, 1024, 128, EpiStoreF32{(float*)(F.ws + WS_YQ), 1024})));
    PHASE(PH_KVPOST_S, ph_kvpost_s(F));
    PHASE(PH_S1_S, ph_s1_s(F));
    PHASE(PH_S2_S, ph_s2_s(F));
    PHASE(PH_ATTN_S, ph_attn_f(F));
    PHASE(PH_MRG_S, ph_mrg_s(F));
    PHASE(PH_WO_S, { pg8::StaticOrder S; S.init(F.ws + WS_MRG, F.ws + WS_WO, MX, DM, DM, F.G, (int)blockIdx.x);
        pg8::gemm_phase(ldsl, pg8::Gemm{DM, (size_t)128 * DM * 2, (size_t)128 * DM * 2, DM * 2, 127}, S, pg8::EpiF32{(float*)(F.ws + WS_Y3), DM}); });
    PHASE(PH_WOPOST_S, ph_wopost_s(F));
    PHASE(PH_GU_S, { pg8::StaticOrder S; S.init(F.ws + WS_XN, F.ws + WS_WGU, MX, 2 * DFF, DM, F.G, (int)blockIdx.x);
        pg8::gemm_phase(ldsl, pg8::Gemm{DM, (size_t)128 * DM * 2, (size_t)128 * DM * 2, DM * 2, 127}, S, pg8::EpiSwigluF{(bf16*)(F.ws + WS_ACT), DFF}); });
    PHASE(PH_DN_S, { pg8::StaticOrder S; S.init(F.ws + WS_ACT, F.ws + WS_WDN, MX, DM, DFF, F.G, (int)blockIdx.x);
        pg8::gemm_phase(ldsl, pg8::Gemm{DFF, (size_t)128 * DFF * 2, (size_t)128 * DFF * 2, DFF * 2, 127}, S, pg8::EpiF32{(float*)(F.ws + WS_Y5), DM}); });
    PHASE(PH_DNPOST_S, ph_dnpost_s(F));
#undef PHASE
}

#ifndef MK_ONE_LAUNCH
#define MK_ONE_LAUNCH 1
#endif
extern "C" void kernel_launch(void* const* d_in, const int* in_sizes, int n_in, void* d_out, int out_size, void* d_ws, size_t ws_size, hipStream_t stream) {
    static int grid = 0;
    if (grid == 0) {
        if (n_in != 19 || out_size != MX * DM || ws_size < WS_END) { fprintf(stderr, "kernel_launch: unexpected shapes n_in %d out %d ws %zu\n", n_in, out_size, ws_size); grid = -1; return; }
        int dev = 0, cus = 0, per_cu = 0;
        hipGetDevice(&dev); hipDeviceGetAttribute(&cus, hipDeviceAttributeMultiprocessorCount, dev);
        if (hipFuncSetAttribute((const void*)mega_fwd, hipFuncAttributeMaxDynamicSharedMemorySize, LDS_BYTES) != hipSuccess) { fprintf(stderr, "kernel_launch: hipFuncSetAttribute failed\n"); grid = -1; return; }
        if (hipOccupancyMaxActiveBlocksPerMultiprocessor(&per_cu, (const void*)mega_fwd, NTHR, LDS_BYTES) != hipSuccess || per_cu < 1) { fprintf(stderr, "kernel_launch: occupancy query gives %d\n", per_cu); per_cu = 1; }
        (void)hipGetLastError();
        grid = cus * 1;
        fprintf(stderr, "kernel_launch: cus %d per_cu %d grid %d ws %zu\n", cus, per_cu, grid, ws_size);
    }
    if (grid < 0) return;
    hipMemsetAsync((char*)d_ws + WS_CTL, 0, CTL_ZERO_BYTES, stream);
    Args a{};
    for (int i = 0; i < 19; ++i) a.in[i] = (const float*)d_in[i];
    a.out = (float*)d_out; a.ws = (unsigned char*)d_ws;
#if MK_ONE_LAUNCH
    a.ph_lo = 0; a.ph_hi = PH_COUNT; a.use_bar = 1;
    void* kargs[] = {&a};
    hipError_t e = hipLaunchCooperativeKernel((const void*)mega_fwd, dim3(grid), dim3(NTHR), kargs, LDS_BYTES, stream);
    if (e != hipSuccess) fprintf(stderr, "kernel_launch: cooperative launch failed: %s\n", hipGetErrorString(e));
#else
    for (int ph = 0; ph < PH_COUNT; ++ph) {
        a.ph_lo = ph; a.ph_hi = ph + 1; a.use_bar = 0;
        hipLaunchKernelGGL(mega_fwd, dim3(grid), dim3(NTHR), LDS_BYTES, stream, a);
    }
#endif
}
```

```cpp
#include <hip/hip_runtime.h>
#include <cstdio>
#include <cstdint>

constexpr int NB = 4, SEQ = 8192, LTOK = 8208, DM = 1024, NMETA = 16;
constexpr int MX = NB * SEQ;
constexpr int MNAT = NB * LTOK;
constexpr int INW = 928, QLR = 256, KVLR = 128, ROPED = 32, NH = 8, DQK = 96, DV = 64;
constexpr int FW = 512, FGD = 128;
constexpr int DFF = 2816;
constexpr int FN1 = 108, FN2 = 76;
constexpr int KVROWS = 33024;
constexpr int META_ROW0 = 32768;
constexpr float EPS = 1e-6f;
constexpr float C2 = 0.10206207261596577f * 1.4426950408889634f;

constexpr size_t MiB = 1u << 20;
constexpr size_t WS_CTL = 0, CTL_ZERO_BYTES = 1 * MiB;
constexpr size_t WS_ROPE = 1 * MiB;
constexpr size_t WS_TW = 3 * MiB;
constexpr size_t WS_WU = 4 * MiB;
constexpr size_t WS_WIN = 5 * MiB;
constexpr size_t WS_WQB = 8 * MiB;
constexpr size_t WS_WKV = 9 * MiB;
constexpr size_t WS_WO = 10 * MiB;
constexpr size_t WS_WGU = 12 * MiB;
constexpr size_t WS_WDN = 23 * MiB;
constexpr size_t WS_DD1 = 29 * MiB;
constexpr size_t WS_D2 = 30 * MiB;
constexpr size_t WS_XN = 32 * MiB;
constexpr size_t WS_ZQ = 97 * MiB;
constexpr size_t WS_ZKV = 113 * MiB;
constexpr size_t WS_Q = 130 * MiB;
constexpr size_t WS_KB = 178 * MiB;
constexpr size_t WS_VB = 227 * MiB;
constexpr size_t WS_X0 = 260 * MiB;
constexpr size_t WS_X1 = 336 * MiB;
constexpr size_t WS_AO = 444 * MiB;
constexpr size_t WS_MRG = 130 * MiB;
constexpr size_t WS_ACT = 260 * MiB;
constexpr size_t WS_Z = 336 * MiB;
constexpr size_t WS_YQ = 336 * MiB;
constexpr size_t WS_Y3 = 194 * MiB;
constexpr size_t WS_Y5 = 32 * MiB;
constexpr size_t WS_END = 508 * MiB;

constexpr int CW_BAR = 4096;

constexpr int RING_BYTES = 131072;
constexpr int LDSCTL_OFF = RING_BYTES, MISC_OFF = LDSCTL_OFF + 320;
constexpr int PTR_OFF = LDSCTL_OFF + 1024;
constexpr int LDS_BYTES = 147456;
constexpr int NWAVES = 8, NTHR = 512;

#define GAS __attribute__((address_space(1)))
#define LAS __attribute__((address_space(3)))
typedef unsigned short bf16;
typedef float f32x4 __attribute__((ext_vector_type(4)));
typedef unsigned u32x4 __attribute__((ext_vector_type(4)));
typedef unsigned u32x2 __attribute__((ext_vector_type(2)));
typedef GAS unsigned gu32;

__device__ __forceinline__ unsigned f2bf(float f) { unsigned u = __builtin_bit_cast(unsigned, f); return (u + 0x7fffu + ((u >> 16) & 1u)) >> 16; }
__device__ __forceinline__ float bf2f(unsigned h) { return __builtin_bit_cast(float, h << 16); }
__device__ __forceinline__ unsigned pk2(float lo, float hi) { return f2bf(lo) | (f2bf(hi) << 16); }
__device__ __forceinline__ float hw_sin(float rev) { return __builtin_amdgcn_sinf(rev); }
__device__ __forceinline__ float hw_cos(float rev) { return __builtin_amdgcn_cosf(rev); }
__device__ const float INV_FREQ[16] = {1.0f, 0.5623413324356079f, 0.3162277638912201f, 0.17782793939113617f, 0.10000000149011612f, 0.05623413249850273f, 0.03162277489900589f, 0.017782794311642647f,
    0.009999999776482582f, 0.005623413249850273f, 0.003162277629598975f, 0.0017782794311642647f, 0.0010000000474974513f, 0.000562341301701963f, 0.0003162277571391314f, 0.00017782794020604342f};
__device__ __forceinline__ int my_tid() { int t = threadIdx.x; asm volatile("" : "+v"(t)); return t; }
#define FRAME_IDS const int tid_ = my_tid(), lane_ = tid_ & 63, wave_ = __builtin_amdgcn_readfirstlane(tid_ >> 6); (void)lane_; (void)wave_
__device__ __forceinline__ float wave_sum(float v) {
#pragma unroll
    for (int o = 1; o < 64; o <<= 1) v += __shfl_xor(v, o);
    return v;
}

#define XB_TMO      128
#define XB_XCNT(j)  (256  + 64 * (j))
#define XB_XSUB(j)  (1280 + 64 * (j))
#define XB_XGEN(j)  (2304 + 64 * (j))
#define XB_TOP      3328
#define XB_TOPGEN   3392
#define XCD_BAR_WORDS 3456
#define XB_SPIN_CAP (1u << 22)
__device__ __forceinline__ unsigned xb_ld(unsigned* p)              { return __hip_atomic_load(p, __ATOMIC_RELAXED, __HIP_MEMORY_SCOPE_AGENT); }
__device__ __forceinline__ unsigned xb_add(unsigned* p, unsigned v) { return __hip_atomic_fetch_add(p, v, __ATOMIC_RELAXED, __HIP_MEMORY_SCOPE_AGENT); }
__device__ __forceinline__ unsigned xb_xcc_id() { return (unsigned)__builtin_amdgcn_s_getreg((3 << 11) | 20) & 0xFu; }
#define XB_SPIN(cond, bar) do { unsigned _sp = 0; while (cond) { __builtin_amdgcn_s_sleep(1); \
    if ((++_sp & 255u) == 0u) { if (xb_ld(&(bar)[XB_TMO])) break; if (_sp > XB_SPIN_CAP) { atomicAdd(&(bar)[XB_TMO], 1u); break; } } } } while (0)
struct XcdBarrier { unsigned* bar; unsigned x; volatile LAS unsigned* st; };
__device__ __forceinline__ XcdBarrier xcd_barrier_post(unsigned* bar, volatile LAS unsigned* st) {
    XcdBarrier b; b.bar = bar; b.x = xb_xcc_id(); b.st = st;
    if (threadIdx.x == 0) (void)xb_add(&bar[XB_XCNT(b.x)], 1u);
    return b;
}
__device__ __forceinline__ void xcd_barrier_complete(unsigned* bar, unsigned x, unsigned& nloc, unsigned& nx) {
    const unsigned G = gridDim.x * gridDim.y * gridDim.z;
    unsigned sum, cnt, mine, sp = 0u;
    for (;;) {
        sum = 0u; cnt = 0u; mine = 0u;
#pragma unroll
        for (unsigned j = 0; j < 16; ++j) { const unsigned c = xb_ld(&bar[XB_XCNT(j)]); sum += c; cnt += (c > 0u) ? 1u : 0u; mine = (j == x) ? c : mine; }
        if (sum == G) break;
        __builtin_amdgcn_s_sleep(1);
        if ((++sp & 255u) == 0u) { if (xb_ld(&bar[XB_TMO])) break; if (sp > XB_SPIN_CAP) { atomicAdd(&bar[XB_TMO], 1u); break; } }
    }
    nloc = mine > 0u ? mine : 1u; nx = cnt > 0u ? cnt : 1u;
}
__device__ __forceinline__ void xcd_barrier(const XcdBarrier& b) {
    asm volatile("s_waitcnt vmcnt(0)" ::: "memory");
    __syncthreads();
    if (threadIdx.x == 0) {
        unsigned* bar = b.bar;
        __builtin_amdgcn_s_waitcnt(0);
        unsigned nloc = b.st[0], nx = b.st[1];
        if (nloc == 0u) { xcd_barrier_complete(bar, b.x, nloc, nx); b.st[0] = nloc; b.st[1] = nx; }
        const unsigned old = xb_add(&bar[XB_XSUB(b.x)], 1u);
        const unsigned gen = old / nloc;
        if (old + 1u == (gen + 1u) * nloc) {
            __builtin_amdgcn_fence(__ATOMIC_RELEASE, "agent");
            asm volatile("s_waitcnt vmcnt(0)" ::: "memory");
            const unsigned og = xb_add(&bar[XB_TOP], 1u);
            const unsigned tg = og / nx;
            if (og + 1u == (tg + 1u) * nx) xb_add(&bar[XB_TOPGEN], 1u);
            else XB_SPIN(xb_ld(&bar[XB_TOPGEN]) == tg, bar);
            __builtin_amdgcn_fence(__ATOMIC_ACQUIRE, "agent");
            xb_add(&bar[XB_XGEN(b.x)], 1u);
            asm volatile("s_waitcnt vmcnt(0)" ::: "memory");
        } else {
            XB_SPIN(xb_ld(&bar[XB_XGEN(b.x)]) == gen, bar);
            __builtin_amdgcn_fence(__ATOMIC_ACQUIRE, "agent");
            asm volatile("s_waitcnt vmcnt(0)" ::: "memory");
        }
    }
    __syncthreads();
}

struct Frame {
    unsigned char* lds;
    int vcu, G;
    float* out; unsigned char* ws;
    __device__ __forceinline__ const float* inp(int k) const {
        const LAS unsigned* t = (const LAS unsigned*)((LAS unsigned char*)lds + PTR_OFF) + 2 * k;
        const unsigned lo = __builtin_amdgcn_readfirstlane(t[0]), hi = __builtin_amdgcn_readfirstlane(t[1]);
        return (const float*)(((unsigned long long)hi << 32) | lo);
    }
};
#define IN_X 0
#define IN_META 1
#define IN_G_PRE 2
#define IN_W_IN 3
#define IN_G_QA 4
#define IN_W_QB 5
#define IN_G_KVA 6
#define IN_W_KVB 7
#define IN_W_FOUR 8
#define IN_B_FOUR 9
#define IN_G_ATTN 10
#define IN_G_FOUR 11
#define IN_W_O 12
#define IN_G_POST 13
#define IN_G_PREFFN 14
#define IN_W_GATE 15
#define IN_W_UP 16
#define IN_W_DOWN 17
#define IN_G_POSTFFN 18


namespace pg8 {
#define PG8_LAS __attribute__((address_space(3)))
typedef unsigned short bf16_t;
typedef short bf16x8 __attribute__((ext_vector_type(8)));
typedef float f32x4 __attribute__((ext_vector_type(4)));
typedef unsigned u32x4 __attribute__((ext_vector_type(4)));
constexpr int BM = 256, BK = 64, HALF = 128, HTB = HALF * BK * 2, STAGE_BYTES = 8 * HTB, NXCD = 8, WGM = 8;
__host__ __device__ __forceinline__ int lds_byte(int r, int c) { const int st = (r >> 4) * 2 + (c >> 5), rr = r & 15, cc = c & 31, ob = rr * 64 + cc * 2; return st * 1024 + (ob ^ (((ob >> 9) & 1) << 5)); }
__host__ __device__ __forceinline__ void stage_rc(int b, int& R, int& C) { const int st = b / 1024, sb = b % 1024, swz = sb ^ (((sb >> 9) & 1) << 5); R = (st >> 1) * 16 + swz / 64; C = (st & 1) * 32 + (swz % 64) / 2; }
__host__ __device__ __forceinline__ int perm32(int rho) { const int n = rho >> 4, i = rho & 15; return 8 * (i >> 2) + 4 * n + (i & 3); }

struct Unit { int pm, pn; const char* a; const char* b; };
struct Gemm { int K; size_t hstepA, hstepB; int a_rowbytes, a_rclamp; };

struct StaticOrder {
    int nM, nN, nwg, G, c; const char* A; const char* Bt; size_t tstepA, tstepB;
    __device__ void init(const void* A_, const void* Bt_, int M, int N, int K, int G_, int c_) { nM = M / BM; nN = N / BM; nwg = nM * nN; G = G_; c = c_; A = (const char*)A_; Bt = (const char*)Bt_; tstepA = (size_t)BM * K * 2; tstepB = tstepA; }
    __device__ bool next(int i, Unit& u) const {
        const long L = (long)i * G + c; if (L >= nwg) return false;
        int wgid = (int)L; { const int q = nwg / NXCD, r = nwg % NXCD, xcd = wgid % NXCD, off = wgid / NXCD; wgid = (xcd < r ? xcd * (q + 1) : r * (q + 1) + (xcd - r) * q) + off; }
        const int nig = WGM * nN, gid = wgid / nig, fm = gid * WGM, gsz = (nM - fm) < WGM ? (nM - fm) : WGM;
        u.pm = fm + ((wgid % nig) % gsz); u.pn = (wgid % nig) / gsz; u.a = A + (size_t)u.pm * tstepA; u.b = Bt + (size_t)u.pn * tstepB; return true;
    }
};

__device__ __forceinline__ unsigned cvt_pk_bf16(float lo, float hi) { unsigned r; asm volatile("v_cvt_pk_bf16_f32 %0, %1, %2" : "=v"(r) : "v"(lo), "v"(hi)); return r; }

struct EpiF32 {
    static constexpr bool PERM = false, ACC_T = true;
    float* C; int ldc;
    __device__ __forceinline__ void operator()(const f32x4 (&acc)[2][2][4][2], const Unit& u, int wr, int wc, int fr, int fq) const {
        const int row0 = u.pm * BM + wr * 64 + fr, col0 = u.pn * BM + wc * 32 + 4 * fq;
#pragma unroll
        for (int ai = 0; ai < 2; ++ai)
#pragma unroll
            for (int m = 0; m < 4; ++m) { float* rowp = C + (size_t)(row0 + ai * HALF + m * 16) * ldc + col0;
#pragma unroll
                for (int bj = 0; bj < 2; ++bj)
#pragma unroll
                    for (int n = 0; n < 2; ++n) *(f32x4*)(rowp + bj * HALF + n * 16) = acc[ai][bj][m][n]; }
    }
};
struct EpiSwigluF {
    static constexpr bool PERM = true, ACC_T = true;
    bf16_t* O; int ldc;
    __device__ __forceinline__ void operator()(const f32x4 (&acc)[2][2][4][2], const Unit& u, int wr, int wc, int fr, int fq) const {
        const int row0 = u.pm * BM + wr * 64 + fr, col0 = u.pn * HALF + wc * 32 + 8 * fq;
#pragma unroll
        for (int ai = 0; ai < 2; ++ai)
#pragma unroll
            for (int m = 0; m < 4; ++m) { bf16_t* rowp = O + (size_t)(row0 + ai * HALF + m * 16) * ldc + col0;
                float o[8];
#pragma unroll
                for (int n = 0; n < 2; ++n)
#pragma unroll
                    for (int j = 0; j < 4; ++j) { const float g = acc[ai][0][m][n][j], up = acc[ai][1][m][n][j]; o[n * 4 + j] = g * __builtin_amdgcn_rcpf(1.0f + __builtin_amdgcn_exp2f(-1.4426950408889634f * g)) * up; }
                u32x4 w; w.x = cvt_pk_bf16(o[0], o[1]); w.y = cvt_pk_bf16(o[2], o[3]); w.z = cvt_pk_bf16(o[4], o[5]); w.w = cvt_pk_bf16(o[6], o[7]);
                *(u32x4*)rowp = w; }
    }
};


struct EpiQ {
    static constexpr bool PERM = true, ACC_T = true;
    bf16_t* Q; const float2* rope;
    __device__ __forceinline__ void operator()(const f32x4 (&acc)[2][2][4][2], const Unit& u, int wr, int wc, int fr, int fq) const {
        const int row0 = u.pm * BM + wr * 64 + fr, gcol0 = u.pn * BM + wc * 32 + 8 * fq;
#pragma unroll
        for (int ai = 0; ai < 2; ++ai)
#pragma unroll
            for (int m = 0; m < 4; ++m) { const int row = row0 + ai * HALF + m * 16; const int l = (row & (SEQ - 1)) + NMETA; bf16_t* qrow = Q + (size_t)row * 768;
#pragma unroll
                for (int bj = 0; bj < 2; ++bj) { const int g8 = (gcol0 + bj * HALF) >> 3, h = g8 / 12, gi = g8 - h * 12;
                    const f32x4 v0 = acc[ai][bj][m][0], v1 = acc[ai][bj][m][1];
                    if (gi < 8) { u32x4 w; w.x = cvt_pk_bf16(v0[0] * C2, v0[1] * C2); w.y = cvt_pk_bf16(v0[2] * C2, v0[3] * C2); w.z = cvt_pk_bf16(v1[0] * C2, v1[1] * C2); w.w = cvt_pk_bf16(v1[2] * C2, v1[3] * C2);
                        *(u32x4*)(qrow + h * 96 + 8 * gi) = w; }
                    else { const int rg = gi - 8; const f32x4 cs0 = *(const f32x4*)(rope + l * 16 + 4 * rg), cs1 = *(const f32x4*)(rope + l * 16 + 4 * rg + 2);
                        const float c[4] = {cs0[0], cs0[2], cs1[0], cs1[2]}, sn[4] = {cs0[1], cs0[3], cs1[1], cs1[3]}; float o1[4], o2[4];
#pragma unroll
                        for (int i = 0; i < 4; ++i) { o1[i] = (v0[i] * c[i] - v1[i] * sn[i]) * C2; o2[i] = (v1[i] * c[i] + v0[i] * sn[i]) * C2; }
                        typedef unsigned u32x2v __attribute__((ext_vector_type(2)));
                        *(u32x2v*)(qrow + h * 96 + 64 + 4 * rg) = (u32x2v){cvt_pk_bf16(o1[0], o1[1]), cvt_pk_bf16(o1[2], o1[3])};
                        *(u32x2v*)(qrow + h * 96 + 80 + 4 * rg) = (u32x2v){cvt_pk_bf16(o2[0], o2[1]), cvt_pk_bf16(o2[2], o2[3])}; } } }
    }
};
struct EpiKV {
    static constexpr bool PERM = true, ACC_T = true;
    bf16_t* KB; bf16_t* VB;
    __device__ __forceinline__ void operator()(const f32x4 (&acc)[2][2][4][2], const Unit& u, int wr, int wc, int fr, int fq) const {
        const int row0 = u.pm * BM + wr * 64 + fr, gcol0 = u.pn * BM + wc * 32 + 8 * fq;
#pragma unroll
        for (int ai = 0; ai < 2; ++ai)
#pragma unroll
            for (int m = 0; m < 4; ++m) { const int row = row0 + ai * HALF + m * 16; if (row >= META_ROW0 + NMETA) continue;
#pragma unroll
                for (int bj = 0; bj < 2; ++bj) { const int gc = gcol0 + bj * HALF; const f32x4 v0 = acc[ai][bj][m][0], v1 = acc[ai][bj][m][1];
                    u32x4 w; w.x = cvt_pk_bf16(v0[0], v0[1]); w.y = cvt_pk_bf16(v0[2], v0[3]); w.z = cvt_pk_bf16(v1[0], v1[1]); w.w = cvt_pk_bf16(v1[2], v1[3]);
                    if (gc < 768) *(u32x4*)(KB + (size_t)row * 768 + gc) = w; else *(u32x4*)(VB + (size_t)row * 512 + gc - 768) = w; } }
    }
};


struct SchedInNat {
    int vcu; const char* XN; const char* W;
    __device__ bool next(int i, Unit& u) const {
        if (i == 0) { u.pm = vcu >> 1; u.pn = vcu & 1; const int b = u.pm >> 5, j = u.pm & 31; u.a = XN + ((size_t)b * LTOK + NMETA + 256 * j) * (DM * 2); u.b = W + (size_t)u.pn * 256 * DM * 2; return true; }
        if (i == 1 && vcu == 0) { u.pm = 128; u.pn = 1; u.a = XN; u.b = W + (size_t)256 * DM * 2; return true; }
        return false;
    }
};
struct SchedInG {
    int vcu; const char* XN; const char* W;
    __device__ bool next(int i, Unit& u) const {
        int gu;
        if (i < 2) gu = vcu + 256 * i; else if (i == 2 && vcu >= 160) gu = 512 + (255 - vcu); else return false;
        const int g = gu & 3, bp = gu >> 2, b = bp / 38, p2 = bp - b * 38;
        u.pm = bp; u.pn = g; u.a = XN + ((size_t)b * LTOK + 2 * p2) * (DM * 2); u.b = W + (size_t)(512 + 256 * g) * DM * 2; return true;
    }
};
struct EpiInNat {
    static constexpr bool PERM = true, ACC_T = true;
    bf16_t* ZQ; bf16_t* ZKV; const float* g_qa; const float* g_kva; const float2* rope; PG8_LAS float* P;
    __device__ __forceinline__ void operator()(const f32x4 (&acc)[2][2][4][2], const Unit& u, int wr, int wc, int fr, int fq) const {
        const bool iscq = (u.pn == 0);
#pragma unroll
        for (int ai = 0; ai < 2; ++ai)
#pragma unroll
            for (int m = 0; m < 4; ++m) { float ss = 0.f;
#pragma unroll
                for (int bj = 0; bj < 2; ++bj) { if (bj == 1 && !iscq) continue;
#pragma unroll
                    for (int n = 0; n < 2; ++n) { const f32x4 x = acc[ai][bj][m][n]; ss += (x[0] * x[0] + x[1] * x[1]) + (x[2] * x[2] + x[3] * x[3]); } }
                ss += __shfl_xor(ss, 16); ss += __shfl_xor(ss, 32);
                if (fq == 0) P[(ai * HALF + wr * 64 + m * 16 + fr) * 4 + wc] = ss; }
        asm volatile("s_waitcnt lgkmcnt(0)" ::: "memory"); __builtin_amdgcn_s_barrier(); asm volatile("" ::: "memory");
        const int trow0 = wr * 64 + fr, col0 = wc * 32 + 8 * fq;
        const int xr0 = u.pm * BM;
        const bool meta = (u.pm == 128);
#pragma unroll
        for (int ai = 0; ai < 2; ++ai)
#pragma unroll
            for (int m = 0; m < 4; ++m) { const int tr = trow0 + ai * HALF + m * 16; const f32x4 pp = *(const PG8_LAS f32x4*)(P + tr * 4);
                const float rstd = 1.0f / sqrtf(((pp[0] + pp[1]) + (pp[2] + pp[3])) * (iscq ? (1.f / 256.f) : (1.f / 128.f)) + EPS);
                if (meta && tr >= NMETA) continue;
                const int orow = meta ? META_ROW0 + tr : xr0 + tr; const int l = meta ? tr : ((xr0 + tr) & (SEQ - 1)) + NMETA;
                if (iscq) {
#pragma unroll
                    for (int bj = 0; bj < 2; ++bj) { const int c = col0 + bj * HALF; const f32x4 v0 = acc[ai][bj][m][0] * rstd * *(const f32x4*)(g_qa + c), v1 = acc[ai][bj][m][1] * rstd * *(const f32x4*)(g_qa + c + 4);
                        u32x4 w; w.x = cvt_pk_bf16(v0[0], v0[1]); w.y = cvt_pk_bf16(v0[2], v0[3]); w.z = cvt_pk_bf16(v1[0], v1[1]); w.w = cvt_pk_bf16(v1[2], v1[3]);
                        *(u32x4*)(ZQ + (size_t)orow * 256 + c) = w; }
                } else {
                    bf16_t* zr = ZKV + (size_t)orow * 256;
                    { const int c = col0; const f32x4 v0 = acc[ai][0][m][0] * rstd * *(const f32x4*)(g_kva + c), v1 = acc[ai][0][m][1] * rstd * *(const f32x4*)(g_kva + c + 4);
                        u32x4 w; w.x = cvt_pk_bf16(v0[0], v0[1]); w.y = cvt_pk_bf16(v0[2], v0[3]); w.z = cvt_pk_bf16(v1[0], v1[1]); w.w = cvt_pk_bf16(v1[2], v1[3]);
                        *(u32x4*)(zr + c) = w; }
                    if (wc == 0) { const f32x4 v0 = acc[ai][1][m][0], v1 = acc[ai][1][m][1]; const f32x4 cs0 = *(const f32x4*)(rope + l * 16 + 4 * fq), cs1 = *(const f32x4*)(rope + l * 16 + 4 * fq + 2);
                        const float c[4] = {cs0[0], cs0[2], cs1[0], cs1[2]}, sn[4] = {cs0[1], cs0[3], cs1[1], cs1[3]}; float o1[4], o2[4];
#pragma unroll
                        for (int i = 0; i < 4; ++i) { o1[i] = v0[i] * c[i] - v1[i] * sn[i]; o2[i] = v1[i] * c[i] + v0[i] * sn[i]; }
                        typedef unsigned u32x2v __attribute__((ext_vector_type(2)));
                        *(u32x2v*)(zr + 128 + 4 * fq) = (u32x2v){cvt_pk_bf16(o1[0], o1[1]), cvt_pk_bf16(o1[2], o1[3])};
                        *(u32x2v*)(zr + 144 + 4 * fq) = (u32x2v){cvt_pk_bf16(o2[0], o2[1]), cvt_pk_bf16(o2[2], o2[3])}; }
                    else *(u32x4*)(zr + 128 + col0) = (u32x4){0u, 0u, 0u, 0u};
                } }
    }
};
struct EpiInG {
    static constexpr bool PERM = false, ACC_T = false;
    bf16_t* X0;
    __device__ __forceinline__ void operator()(const f32x4 (&acc)[2][2][4][2], const Unit& u, int wr, int wc, int fr, int fq) const {
        const int b = u.pm / 38, p2 = u.pm - b * 38, g = u.pn;
        typedef unsigned u32x2v __attribute__((ext_vector_type(2)));
#pragma unroll
        for (int ai = 0; ai < 2; ++ai)
#pragma unroll
            for (int bj = 0; bj < 2; ++bj)
#pragma unroll
                for (int n = 0; n < 2; ++n) { const int cc = g * 128 + wc * 32 + n * 16 + fr; bf16_t* dst = X0 + ((((size_t)b * 512 + cc) * FN2 + 2 * p2 + ai) * 2 + bj) * 128 + wr * 64 + 4 * fq;
#pragma unroll
                    for (int m = 0; m < 4; ++m) { const f32x4 v = acc[ai][bj][m][n]; *(u32x2v*)(dst + m * 16) = (u32x2v){cvt_pk_bf16(v[0], v[1]), cvt_pk_bf16(v[2], v[3])}; } }
    }
};
struct EpiS1 {
    static constexpr bool PERM = false, ACC_T = false;
    bf16_t* X1; const float2* tw;
    __device__ __forceinline__ void operator()(const f32x4 (&acc)[2][2][4][2], const Unit& u, int wr, int wc, int fr, int fq) const {
        typedef unsigned u32x2v __attribute__((ext_vector_type(2)));
#pragma unroll
        for (int ai = 0; ai < 2; ++ai)
#pragma unroll
            for (int m = 0; m < 4; ++m) { const int it = u.pm * BM + ai * HALF + wr * 64 + m * 16 + 4 * fq; const int q = it / FN2, l2 = it - q * FN2, cc = q & 511, b = q >> 9;
#pragma unroll
                for (int n = 0; n < 2; ++n) { const int k1 = wc * 32 + n * 16 + fr; if (k1 >= FN1) continue;
                    const f32x4 re = acc[ai][0][m][n], im = acc[ai][1][m][n]; float br[4], bi[4];
#pragma unroll
                    for (int i = 0; i < 4; ++i) { const float2 t = tw[(l2 + i) * k1]; br[i] = re[i] * t.x + im[i] * t.y; bi[i] = im[i] * t.x - re[i] * t.y; }
                    bf16_t* dst = X1 + ((((size_t)b * FN1 + k1) * 512 + cc) * 2) * 128 + l2;
                    *(u32x2v*)dst = (u32x2v){cvt_pk_bf16(br[0], br[1]), cvt_pk_bf16(br[2], br[3])};
                    *(u32x2v*)(dst + 128) = (u32x2v){cvt_pk_bf16(bi[0], bi[1]), cvt_pk_bf16(bi[2], bi[3])}; } }
    }
};
struct EpiS2 {
    static constexpr bool PERM = false, ACC_T = false;
    bf16_t* AO; const float* bias;
    __device__ __forceinline__ void operator()(const f32x4 (&acc)[2][2][4][2], const Unit& u, int wr, int wc, int fr, int fq) const {
        typedef unsigned u32x2v __attribute__((ext_vector_type(2)));
#pragma unroll
        for (int ai = 0; ai < 2; ++ai)
#pragma unroll
            for (int m = 0; m < 4; ++m) { const int it = u.pm * BM + ai * HALF + wr * 64 + m * 16 + 4 * fq; const int cc = it & 511, q = it >> 9, b = q / FN1, k1 = q - b * FN1;
                const f32x4 bv = *(const f32x4*)(bias + cc);
#pragma unroll
                for (int n = 0; n < 2; ++n) { const int k2 = wc * 32 + n * 16 + fr; const int k = k1 + FN1 * k2; if (k2 >= FN2 || k < NMETA) continue;
                    const f32x4 v = acc[ai][0][m][n] + bv;
                    *(u32x2v*)(AO + ((size_t)b * SEQ + k - NMETA) * 1024 + 512 + cc) = (u32x2v){cvt_pk_bf16(v[0], v[1]), cvt_pk_bf16(v[2], v[3])}; } }
    }
};

template <class Epi, class Sched>
__device__ __forceinline__ void gemm_phase(PG8_LAS unsigned char* lds, const Gemm g, const Sched& S, const Epi& E) {
    const int tid = my_tid(), wid = __builtin_amdgcn_readfirstlane(tid >> 6), lane = tid & 63, wr = wid >> 2, wc = wid & 3, fr = lane & 15, fq = lane >> 4;
    const int K = g.K, nt = K / BK;
    unsigned voffA[2], voffB[2];
#pragma unroll
    for (int i = 0; i < 2; ++i) { int R, C; stage_rc(tid * 16 + i * 8192, R, C); const int Rb = Epi::PERM ? ((R & ~31) + perm32(R & 31)) : R; const int Ra = R < g.a_rclamp ? R : g.a_rclamp;
        voffA[i] = (unsigned)(Ra * g.a_rowbytes + C * 2); voffB[i] = (unsigned)(Rb * K + C) * 2u; }
    const size_t kstep = (size_t)(BK * 2);
    const size_t hstepA = g.hstepA, hstepB = g.hstepB;
    const unsigned ldsw = (unsigned)wid * 1024u;
    const int aoff = lds_byte(wr * 64 + fr, fq * 8), boff = lds_byte(wc * 32 + fr, fq * 8);
#define PG8_SA(b, h) (((b) * 2 + (h)) * HTB)
#define PG8_SB(b, h) ((4 + (b) * 2 + (h)) * HTB)
#define PG8_STAGE(bufoff, gbase, voff) do { _Pragma("unroll") for (int _i = 0; _i < 2; ++_i) \
        __builtin_amdgcn_global_load_lds((const unsigned*)((const char*)(gbase) + (voff)[_i]), (PG8_LAS unsigned*)(lds + (bufoff) + ldsw + _i * 8192), 16, 0, 0); } while (0)
#define PG8_LDA(dst, b, h) do { _Pragma("unroll") for (int m = 0; m < 4; ++m) _Pragma("unroll") for (int k = 0; k < 2; ++k) dst[m][k] = *(const PG8_LAS bf16x8*)(lds + PG8_SA(b, h) + aoff + m * 2048 + k * 1024); } while (0)
#define PG8_LDB(dst, b, h) do { _Pragma("unroll") for (int n = 0; n < 2; ++n) _Pragma("unroll") for (int k = 0; k < 2; ++k) dst[n][k] = *(const PG8_LAS bf16x8*)(lds + PG8_SB(b, h) + boff + n * 2048 + k * 1024); } while (0)
#define PG8_MMA(ai, bj, At, Bt) do { __builtin_amdgcn_s_setprio(1); _Pragma("unroll") for (int m = 0; m < 4; ++m) _Pragma("unroll") for (int n = 0; n < 2; ++n) _Pragma("unroll") for (int k = 0; k < 2; ++k) \
        acc[ai][bj][m][n] = Epi::ACC_T ? __builtin_amdgcn_mfma_f32_16x16x32_bf16(Bt[n][k], At[m][k], acc[ai][bj][m][n], 0, 0, 0) : __builtin_amdgcn_mfma_f32_16x16x32_bf16(At[m][k], Bt[n][k], acc[ai][bj][m][n], 0, 0, 0); __builtin_amdgcn_s_setprio(0); } while (0)
#define PG8_WAIT_V(n) asm volatile("s_waitcnt vmcnt(" #n ")" ::: "memory")
#define PG8_WAIT_L(n) asm volatile("s_waitcnt lgkmcnt(" #n ")" ::: "memory")
#define PG8_BAR __builtin_amdgcn_s_barrier()
#define PG8_SCHED __builtin_amdgcn_sched_barrier(0)
    Unit cur, nxt; int ui = 0;
    if (!S.next(0, cur)) return;
    f32x4 acc[2][2][4][2];
#pragma unroll
    for (int a = 0; a < 2; ++a)
#pragma unroll
        for (int b = 0; b < 2; ++b)
#pragma unroll
            for (int m = 0; m < 4; ++m)
#pragma unroll
                for (int n = 0; n < 2; ++n) acc[a][b][m][n] = (f32x4){0.f, 0.f, 0.f, 0.f};
    bf16x8 At[4][2], B0[2][2], B1[2][2];
    const char* cA = cur.a; const char* cB = cur.b;
    PG8_STAGE(PG8_SB(0, 0), cB, voffB); PG8_STAGE(PG8_SB(0, 1), cB + hstepB, voffB); PG8_STAGE(PG8_SA(0, 0), cA, voffA); PG8_STAGE(PG8_SA(0, 1), cA + hstepA, voffA);
    if (wr == 1) PG8_BAR;
    PG8_WAIT_V(2); PG8_BAR;
    PG8_STAGE(PG8_SB(1, 0), cB + kstep, voffB); PG8_STAGE(PG8_SA(1, 0), cA + kstep, voffA); PG8_STAGE(PG8_SB(1, 1), cB + hstepB + kstep, voffB);
    PG8_WAIT_V(6); PG8_BAR;
    for (;;) {
        const bool has_next = S.next(ui + 1, nxt);
        const char* nA = has_next ? nxt.a : cA; const char* nB = has_next ? nxt.b : cB;
        for (int t = 0; t < nt; t += 2) {
            const bool last = (t == nt - 2);
            const char* a1 = cA + (size_t)(t + 1) * kstep;
            const char* a2 = last ? nA : cA + (size_t)(t + 2) * kstep; const char* b2 = last ? nB : cB + (size_t)(t + 2) * kstep;
            const char* a3 = a2 + kstep; const char* b3 = b2 + kstep;
            PG8_LDB(B0, 0, 0); PG8_LDB(B1, 0, 1); PG8_SCHED; PG8_LDA(At, 0, 0); PG8_STAGE(PG8_SA(1, 1), a1 + hstepA, voffA);
            PG8_WAIT_V(8); PG8_WAIT_L(0); PG8_BAR; PG8_MMA(0, 0, At, B0); PG8_MMA(0, 1, At, B1); PG8_BAR; PG8_SCHED;
            PG8_LDA(At, 0, 1); PG8_STAGE(PG8_SB(0, 0), b2, voffB); PG8_STAGE(PG8_SB(0, 1), b2 + hstepB, voffB); PG8_STAGE(PG8_SA(0, 0), a2, voffA);
            PG8_WAIT_V(8); PG8_WAIT_L(0); PG8_BAR; PG8_MMA(1, 0, At, B0); PG8_MMA(1, 1, At, B1); PG8_BAR; PG8_SCHED;
            PG8_LDB(B0, 1, 0); PG8_LDB(B1, 1, 1); PG8_SCHED; PG8_LDA(At, 1, 0); PG8_STAGE(PG8_SA(0, 1), a2 + hstepA, voffA);
            PG8_WAIT_V(8); PG8_WAIT_L(0); PG8_BAR; PG8_MMA(0, 0, At, B0); PG8_MMA(0, 1, At, B1); PG8_BAR; PG8_SCHED;
            PG8_LDA(At, 1, 1); PG8_STAGE(PG8_SB(1, 0), b3, voffB); PG8_STAGE(PG8_SB(1, 1), b3 + hstepB, voffB); PG8_STAGE(PG8_SA(1, 0), a3, voffA);
            PG8_WAIT_V(8); PG8_WAIT_L(0); PG8_BAR; PG8_MMA(1, 0, At, B0); PG8_MMA(1, 1, At, B1); PG8_BAR; PG8_SCHED;
        }
        if (wr == 0) PG8_BAR;
        E(acc, cur, wr, wc, fr, fq);
        if (!has_next) break;
#pragma unroll
        for (int a = 0; a < 2; ++a)
#pragma unroll
            for (int b = 0; b < 2; ++b)
#pragma unroll
                for (int m = 0; m < 4; ++m)
#pragma unroll
                    for (int n = 0; n < 2; ++n) acc[a][b][m][n] = (f32x4){0.f, 0.f, 0.f, 0.f};
        cur = nxt; cA = nA; cB = nB; ++ui;
        if (wr == 1) PG8_BAR;
    }
    PG8_WAIT_V(0);
    PG8_BAR;
#undef PG8_SA
#undef PG8_SB
#undef PG8_STAGE
#undef PG8_LDA
#undef PG8_LDB
#undef PG8_MMA
#undef PG8_WAIT_V
#undef PG8_WAIT_L
#undef PG8_BAR
#undef PG8_SCHED
}
}

template <class Dest>
__device__ __forceinline__ void transpose_item(const float* W, int K, int N, bf16* WT, int ldk, const Dest& dest, LAS float* scr, int item, int lane) {
    const int nblk = N / 32, kb = item / nblk, nb = item % nblk, k0 = 64 * kb, n0 = 32 * nb;
#pragma unroll 8
    for (int i = 0; i < 32; ++i) { const int kk = 2 * i + (lane >> 5); scr[kk * 33 + (lane & 31)] = W[(size_t)(k0 + kk) * N + n0 + (lane & 31)]; }
    asm volatile("s_waitcnt lgkmcnt(0)" ::: "memory");
    const int c = lane & 7;
#pragma unroll
    for (int j = 0; j < 4; ++j) { const int n = (lane >> 3) + 8 * j; const LAS float* sp = scr + (8 * c) * 33 + n;
        u32x4 o; o.x = pk2(sp[0 * 33], sp[1 * 33]); o.y = pk2(sp[2 * 33], sp[3 * 33]); o.z = pk2(sp[4 * 33], sp[5 * 33]); o.w = pk2(sp[6 * 33], sp[7 * 33]);
        const int dr = dest(n0 + n);
        if (dr >= 0) *(u32x4*)(WT + (size_t)dr * ldk + k0 + 8 * c) = o; }
    asm volatile("s_waitcnt lgkmcnt(0)" ::: "memory");
}
struct DestId { int off; __device__ __forceinline__ int operator()(int n) const { return off + n; } };
struct DestWin { __device__ __forceinline__ int operator()(int n) const { if (n < 384) return n; if (n >= 416) return -1; const int j = (n - 384) & 15, x2 = (n >= 400); return 384 + 8 * (j >> 2) + 4 * x2 + (j & 3); } };
struct DestQB { __device__ __forceinline__ int operator()(int n) const { const int h = n / 96, d = n - h * 96; if (d < 64) return n; const int j = (d - 64) & 15, x2 = (d >= 80); return h * 96 + 64 + 8 * (j >> 2) + 4 * x2 + (j & 3); } };
struct DestKV { __device__ __forceinline__ int operator()(int n) const { const int h = n >> 7, d = n & 127; return d < 64 ? h * 96 + d : 768 + h * 64 + d - 64; } };
struct DestGU { int up; __device__ __forceinline__ int operator()(int n) const { return (n >> 7) * 256 + up * 128 + (n & 127); } };


namespace fa {
using bf16x8 = __attribute__((ext_vector_type(8))) short;
using s16x4  = __attribute__((ext_vector_type(4))) short;
using f32x16 = __attribute__((ext_vector_type(16))) float;
constexpr int SHM_V = 64 * 64 * 2, SHM_K = 64 * 256, LDS_V = 0, LDS_K = 2 * SHM_V, LDS_WS = LDS_K + 2 * SHM_K;
constexpr int NT = 129;
constexpr float THRL = 8.0f;
#define FA_KSWZ(row, colB) ((row) * 256 + ((colB) ^ (((row) & 7) << 4)))
#define FA_SBAR() __builtin_amdgcn_sched_barrier(0)
__device__ __forceinline__ int crow(int r, int hi) { return (r & 3) + 8 * (r >> 2) + 4 * hi; }
__device__ __forceinline__ unsigned cvtpk(float lo, float hi) { unsigned r; asm volatile("v_cvt_pk_bf16_f32 %0, %1, %2" : "=v"(r) : "v"(lo), "v"(hi)); return r; }
__device__ __forceinline__ void partialSM(f32x16& p0, f32x16& p1, float& m_reg, float& alpha) {
    float pmax = p0[0];
#pragma unroll
    for (int r = 1; r < 16; ++r) pmax = fmaxf(pmax, p0[r]);
#pragma unroll
    for (int r = 0; r < 16; ++r) pmax = fmaxf(pmax, p1[r]);
    { auto rr = __builtin_amdgcn_permlane32_swap(__float_as_uint(pmax), __float_as_uint(pmax), false, false); pmax = fmaxf(__uint_as_float(rr[0]), __uint_as_float(rr[1])); }
    float mn;
    if (__builtin_expect(__all(pmax - m_reg <= THRL), 1)) { mn = m_reg; alpha = 1.f; }
    else { mn = fmaxf(m_reg, pmax); alpha = __builtin_amdgcn_exp2f(m_reg - mn); m_reg = mn; }
#pragma unroll
    for (int r = 0; r < 16; ++r) p0[r] -= mn;
#pragma unroll
    for (int r = 0; r < 16; ++r) p1[r] -= mn;
#pragma unroll
    for (int r = 0; r < 16; ++r) p0[r] = __builtin_amdgcn_exp2f(p0[r]);
}
__device__ __forceinline__ void finishSM(f32x16& p0, f32x16& p1, float alpha, float& l_reg, bf16x8& pa0, bf16x8& pa1, bf16x8& pa2, bf16x8& pa3) {
#pragma unroll
    for (int r = 0; r < 16; ++r) p1[r] = __builtin_amdgcn_exp2f(p1[r]);
    float ps = 0;
#pragma unroll
    for (int r = 0; r < 16; ++r) ps += p0[r];
#pragma unroll
    for (int r = 0; r < 16; ++r) ps += p1[r];
    { auto rr = __builtin_amdgcn_permlane32_swap(__float_as_uint(ps), __float_as_uint(ps), false, false); ps = __uint_as_float(rr[0]) + __uint_as_float(rr[1]); }
    l_reg = l_reg * alpha + ps;
#define FA_PK4(P, BASE, OUT) do { unsigned a0 = cvtpk(P[BASE + 0], P[BASE + 1]), a1 = cvtpk(P[BASE + 2], P[BASE + 3]);   \
    unsigned b0 = cvtpk(P[BASE + 4], P[BASE + 5]), b1 = cvtpk(P[BASE + 6], P[BASE + 7]);                              \
    auto r0 = __builtin_amdgcn_permlane32_swap(a0, b0, false, false); auto r1 = __builtin_amdgcn_permlane32_swap(a1, b1, false, false); \
    u32x4 w = {r0[0], r1[0], r0[1], r1[1]}; OUT = __builtin_bit_cast(bf16x8, w); } while (0)
    FA_PK4(p0, 0, pa0); FA_PK4(p0, 8, pa1); FA_PK4(p1, 0, pa2); FA_PK4(p1, 8, pa3);
#undef FA_PK4
}
__device__ __forceinline__ void qkt(f32x16& p0, f32x16& p1, const LAS unsigned char* Ks, const bf16x8* qr, int r32, int hi) {
    p0 = f32x16{}; p1 = f32x16{};
#pragma unroll
    for (int d0 = 0; d0 < 6; ++d0) { const int cb = (d0 * 16 + hi * 8) * 2;
        const bf16x8 b0 = *(const LAS bf16x8*)(Ks + FA_KSWZ(r32, cb));
        const bf16x8 b1 = *(const LAS bf16x8*)(Ks + FA_KSWZ(32 + r32, cb));
        p0 = __builtin_amdgcn_mfma_f32_32x32x16_bf16(b0, qr[d0], p0, 0, 0, 0);
        p1 = __builtin_amdgcn_mfma_f32_32x32x16_bf16(b1, qr[d0], p1, 0, 0, 0); }
}
__device__ __forceinline__ int v_st(int k, int c) { const int kk = (k & ~0xC) | ((k & 4) << 1) | ((k & 8) >> 1); return ((kk >> 3) * 2 + (c >> 5)) * 512 + ((kk & 7) * 32 + (c & 31)) * 2; }
__device__ __forceinline__ int v_rd_base(int lane) { return ((lane & 3) << 3) | (((lane >> 2) & 3) << 6) | (((lane >> 4) & 1) << 5) | (((lane >> 5) & 1) << 8); }
constexpr int v_rd_off(int d0, int ks, int half) { return d0 * 512 + ks * 2048 + half * 1024; }
template <int OFF> __device__ __forceinline__ s16x4 tr_read(int vb) { s16x4 r; asm volatile("ds_read_b64_tr_b16 %0, %1 offset:%2" : "=&v"(r) : "v"(vb), "i"(OFF) : "memory"); return r; }
template <int D0> __device__ __forceinline__ void pv_one(f32x16& od, int vb, bf16x8 pa0, bf16x8 pa1, bf16x8 pa2, bf16x8 pa3) {
    const s16x4 l0 = tr_read<v_rd_off(D0, 0, 0)>(vb), h0 = tr_read<v_rd_off(D0, 0, 1)>(vb), l1 = tr_read<v_rd_off(D0, 1, 0)>(vb), h1 = tr_read<v_rd_off(D0, 1, 1)>(vb);
    const s16x4 l2 = tr_read<v_rd_off(D0, 2, 0)>(vb), h2 = tr_read<v_rd_off(D0, 2, 1)>(vb), l3 = tr_read<v_rd_off(D0, 3, 0)>(vb), h3 = tr_read<v_rd_off(D0, 3, 1)>(vb);
    asm volatile("s_waitcnt lgkmcnt(0)" ::: "memory"); FA_SBAR();
#define FA_PK(L, H) (bf16x8){L[0], L[1], L[2], L[3], H[0], H[1], H[2], H[3]}
    od = __builtin_amdgcn_mfma_f32_32x32x16_bf16(pa0, FA_PK(l0, h0), od, 0, 0, 0);
    od = __builtin_amdgcn_mfma_f32_32x32x16_bf16(pa1, FA_PK(l1, h1), od, 0, 0, 0);
    od = __builtin_amdgcn_mfma_f32_32x32x16_bf16(pa2, FA_PK(l2, h2), od, 0, 0, 0);
    od = __builtin_amdgcn_mfma_f32_32x32x16_bf16(pa3, FA_PK(l3, h3), od, 0, 0, 0);
#undef FA_PK
}
__device__ __forceinline__ void pv_d0(f32x16* o, int vb, bf16x8 pa0, bf16x8 pa1, bf16x8 pa2, bf16x8 pa3) { pv_one<0>(o[0], vb, pa0, pa1, pa2, pa3); pv_one<1>(o[1], vb, pa0, pa1, pa2, pa3); }

__device__ __forceinline__ void attn_unit(int b, int h, int xr0, const bf16* __restrict__ Q, const bf16* __restrict__ KB, const bf16* __restrict__ VB, bf16* __restrict__ AO, LAS unsigned char* lds) {
    const int tid = my_tid(), wid = tid >> 6, lane = tid & 63, r32 = lane & 31, hi = lane >> 5;
    LAS unsigned char* V_lds = lds + LDS_V; LAS unsigned char* K_lds = lds + LDS_K;
    LAS float* ws = (LAS float*)(lds + LDS_WS) + wid * 64; LAS float* li_l = ws; LAS float* al_l = ws + 32;
    float m_reg = -1e30f, l_reg = 0; f32x16 o[2] = {}; bf16x8 qr[6];
    const bf16* Qw = Q + (size_t)(xr0 + wid * 32 + r32) * 768 + h * 96 + hi * 8;
#pragma unroll
    for (int d0 = 0; d0 < 6; ++d0) qr[d0] = *(const bf16x8*)(Qw + d0 * 16);
    const int srow = tid >> 3, sch = tid & 7, srow2 = (tid >> 2) & 63, sch2 = 8 + (tid & 3); const bool has2 = tid < 256;
    const int vst = v_st(srow, sch * 8), kst1 = FA_KSWZ(srow, sch * 16), kst2 = FA_KSWZ(srow2, sch2 * 16);
    const int vb0 = (int)(uintptr_t)V_lds + v_rd_base(lane);
    const bf16* Kh = KB + h * 96; const bf16* Vh = VB + h * 64;
    bf16x8 sv[2], sk1[2], sk2[2];
#define FA_KROW(t) ((t) < 128 ? (size_t)b * SEQ + (size_t)(t) * 64 : (size_t)META_ROW0)
#define FA_SLOAD(i, t) do { const size_t kr_ = FA_KROW(t); sv[i] = *(const bf16x8*)(Vh + (kr_ + srow) * 512 + sch * 8); sk1[i] = *(const bf16x8*)(Kh + (kr_ + srow) * 768 + sch * 8); \
        if (has2) sk2[i] = *(const bf16x8*)(Kh + (kr_ + srow2) * 768 + sch2 * 8); } while (0)
#define FA_SWRITE(bufi, i) do { *(LAS bf16x8*)(V_lds + (bufi) * SHM_V + vst) = sv[i]; *(LAS bf16x8*)(K_lds + (bufi) * SHM_K + kst1) = sk1[i]; if (has2) *(LAS bf16x8*)(K_lds + (bufi) * SHM_K + kst2) = sk2[i]; } while (0)
#define FA_RESC(a) do { if (__any((a) < 1.f)) { if (hi == 0) al_l[r32] = (a); asm volatile("s_waitcnt lgkmcnt(0)" ::: "memory"); \
        _Pragma("unroll") for (int d = 0; d < 2; ++d) _Pragma("unroll") for (int r = 0; r < 16; ++r) o[d][r] *= al_l[crow(r, hi)]; } } while (0)
    f32x16 pA0, pA1, pB0, pB1; float alA, alB; bf16x8 pa0, pa1, pa2, pa3;
    FA_SLOAD(0, 0); FA_SWRITE(0, 0); __syncthreads();
    qkt(pA0, pA1, K_lds, qr, r32, hi); partialSM(pA0, pA1, m_reg, alA);
    FA_SLOAD(1, 1); FA_SLOAD(0, 2);
    FA_SWRITE(1, 1); __syncthreads();
    for (int j = 1; j + 1 < NT; j += 2) {
        FA_SBAR(); qkt(pB0, pB1, K_lds + SHM_K, qr, r32, hi);
        finishSM(pA0, pA1, alA, l_reg, pa0, pa1, pa2, pa3); FA_SBAR();
        if (j + 2 < NT) FA_SLOAD(1, j + 2); FA_SBAR();
        pv_d0(o, vb0, pa0, pa1, pa2, pa3); partialSM(pB0, pB1, m_reg, alB);
        __syncthreads(); FA_SWRITE(0, 0);
        FA_RESC(alB); __syncthreads();
        FA_SBAR(); qkt(pA0, pA1, K_lds, qr, r32, hi);
        finishSM(pB0, pB1, alB, l_reg, pa0, pa1, pa2, pa3); FA_SBAR();
        if (j + 3 < NT) FA_SLOAD(0, j + 3); FA_SBAR();
        if (j + 1 == NT - 1) {
#pragma unroll
            for (int r = 8; r < 16; ++r) pA0[r] = -1e30f;
#pragma unroll
            for (int r = 0; r < 16; ++r) pA1[r] = -1e30f;
        }
        pv_d0(o, vb0 + SHM_V, pa0, pa1, pa2, pa3); partialSM(pA0, pA1, m_reg, alA);
        __syncthreads(); if (j + 2 < NT) FA_SWRITE(1, 1);
        FA_RESC(alA); __syncthreads();
    }
    finishSM(pA0, pA1, alA, l_reg, pa0, pa1, pa2, pa3); FA_SBAR();
    pv_d0(o, vb0, pa0, pa1, pa2, pa3);
    if (hi == 0) li_l[r32] = l_reg; asm volatile("s_waitcnt lgkmcnt(0)" ::: "memory");
    float rli[16];
#pragma unroll
    for (int r = 0; r < 16; ++r) rli[r] = __builtin_amdgcn_rcpf(li_l[crow(r, hi)]);
    bf16* Ow = AO + (size_t)(xr0 + wid * 32) * 1024 + h * 64;
#pragma unroll
    for (int r = 0; r < 16; ++r) { const int orow = crow(r, hi);
#pragma unroll
        for (int d0 = 0; d0 < 2; ++d0) Ow[(size_t)orow * 1024 + d0 * 32 + r32] = (bf16)f2bf(o[d0][r] * rli[r]); }
    __syncthreads();
#undef FA_KROW
#undef FA_SLOAD
#undef FA_SWRITE
#undef FA_RESC
}
}
__device__ __forceinline__ void ph_attn_f(Frame& F) {
    FRAME_IDS;
    const bf16* Q = (const bf16*)(F.ws + WS_Q); const bf16* KB = (const bf16*)(F.ws + WS_KB); const bf16* VB = (const bf16*)(F.ws + WS_VB); bf16* AO = (bf16*)(F.ws + WS_AO);
    const int npx = F.G / 8;
    const int xg = F.vcu / npx, loc = F.vcu % npx;
    for (int i = 0; i < 4; ++i) {
        const int bh = xg * 4 + i;
        for (int qb = loc; qb < 32; qb += npx) fa::attn_unit(bh >> 3, bh & 7, (bh >> 3) * SEQ + qb * 256, Q, KB, VB, AO, (LAS unsigned char*)F.lds);
    }
}

__device__ __forceinline__ void rms_row_to_bf16(const float* xrow, const float* gain, bf16* orow, int lane) {
    const f32x4* xr = (const f32x4*)xrow + lane; f32x4 v[4]; float s = 0.f;
#pragma unroll
    for (int j = 0; j < 4; ++j) { v[j] = xr[64 * j]; s += (v[j].x * v[j].x + v[j].y * v[j].y) + (v[j].z * v[j].z + v[j].w * v[j].w); }
    const float rstd = 1.0f / sqrtf(wave_sum(s) * (1.f / DM) + EPS);
    unsigned long long* o8 = (unsigned long long*)orow + lane;
#pragma unroll
    for (int j = 0; j < 4; ++j) { const f32x4 g = ((const f32x4*)gain)[lane + 64 * j];
        o8[64 * j] = (unsigned long long)pk2(v[j].x * rstd * g.x, v[j].y * rstd * g.y) | ((unsigned long long)pk2(v[j].z * rstd * g.z, v[j].w * rstd * g.w) << 32); }
}

__device__ __forceinline__ void ph_prologue(Frame& F) {
    FRAME_IDS;
    const int gw = F.vcu * NWAVES + wave_, NGW = F.G * NWAVES;
    const int gt = F.vcu * NTHR + tid_, NGT = F.G * NTHR;
    bf16* XN = (bf16*)(F.ws + WS_XN);
    for (int r = gw; r < MNAT; r += NGW) {
        const int b = r / LTOK, l = r % LTOK;
        const float* src = l < NMETA ? F.inp(IN_META) + (size_t)l * DM : F.inp(IN_X) + ((size_t)b * SEQ + (l - NMETA)) * DM;
        rms_row_to_bf16(src, F.inp(IN_G_PRE), XN + (size_t)r * DM, lane_);
    }
    float2* rope = (float2*)(F.ws + WS_ROPE);
    for (int i = gt; i < LTOK * 16; i += NGT) {
        const int l = i >> 4, j = i & 15;
        const float ang = (float)l * INV_FREQ[j];
        const double rev = (double)ang * 0.15915494309189535; const float fr = (float)(rev - floor(rev));
        rope[i] = make_float2(hw_cos(fr), hw_sin(fr));
    }
    float2* tw = (float2*)(F.ws + WS_TW);
    for (int i = gt; i < LTOK; i += NGT) { const float fr = (float)i / (float)LTOK; tw[i] = make_float2(hw_cos(fr), hw_sin(fr)); }
    float* WU = (float*)(F.ws + WS_WU);
    const float norm = 1.0f / sqrtf((float)LTOK * (float)FGD);
    for (int i = gt; i < 4 * 128 * 2 * 128; i += NGT) {
        const int d = i & 127, p = (i >> 7) & 1, c = (i >> 8) & 127, g = i >> 15;
        const float* wf = F.inp(IN_W_FOUR) + (size_t)g * 128 * 128 + d;
        float acc = 0.f;
        for (int j = 0; j < 128; ++j) { const float fr = (float)((c * j) & 127) * (1.0f / 128.0f); acc += (p ? -hw_sin(fr) : hw_cos(fr)) * wf[(size_t)j * 128]; }
        WU[i] = acc * norm;
    }
    {
        LAS float* scr = (LAS float*)((LAS unsigned char*)F.lds + wave_ * 16384);
        constexpr int I_O = (DM / 64) * (DM / 32), I_G = (DM / 64) * (DFF / 32), I_D = (DFF / 64) * (DM / 32), I_QB = (256 / 64) * (768 / 32), I_KV = (128 / 64) * (1024 / 32);
        constexpr int I_IN = (DM / 64) * (INW / 32);
        for (int it = gw; it < I_IN; it += NGW) transpose_item(F.inp(IN_W_IN), DM, INW, (bf16*)(F.ws + WS_WIN), DM, DestWin{}, scr, it, lane_);
        for (int i = gt; i < 96 * DM / 8; i += NGT) ((u32x4*)(F.ws + WS_WIN + (size_t)416 * DM * 2))[i] = (u32x4){0u, 0u, 0u, 0u};
        for (int i = gt; i < 65536; i += NGT) { const int r = i >> 8, c = i & 255, part = r >> 7, k1 = r & 127, p = c >> 7, l1 = c & 127; float v = 0.f;
            if (k1 < FN1 && l1 < FN1) { const float fr = (float)((k1 * l1) % FN1) / (float)FN1; v = (part == p) ? hw_cos(fr) : (part ? -hw_sin(fr) : hw_sin(fr)); }
            ((bf16*)(F.ws + WS_DD1))[i] = (bf16)f2bf(v);
            float v2 = 0.f;
            if (r < FN2 && l1 < FN2) { const float fr = (float)((r * l1) % FN2) / (float)FN2; v2 = p ? hw_sin(fr) : hw_cos(fr); }
            ((bf16*)(F.ws + WS_D2))[i] = (bf16)f2bf(v2); }
        for (int it = gw; it < I_QB + I_KV; it += NGW) {
            if (it < I_QB) transpose_item(F.inp(IN_W_QB), 256, 768, (bf16*)(F.ws + WS_WQB), 256, DestQB{}, scr, it, lane_);
            else transpose_item(F.inp(IN_W_KVB), 128, 1024, (bf16*)(F.ws + WS_WKV), 256, DestKV{}, scr, it - I_QB, lane_);
        }
        for (int i = gt; i < 1280 * 256; i += NGT) { const int row = i >> 8, k = i & 255; const int hd = row % 96; const bool pick = row < 768 && hd >= 64;
            if (k >= 128 || pick) ((bf16*)(F.ws + WS_WKV))[i] = (pick && k == 128 + hd - 64) ? (bf16)0x3F80 : (bf16)0; }
        const float* w_o = F.inp(IN_W_O); const float* w_g = F.inp(IN_W_GATE); const float* w_u = F.inp(IN_W_UP); const float* w_d = F.inp(IN_W_DOWN);
        for (int it = gw; it < I_O + 2 * I_G + I_D; it += NGW) {
            int r = it;
            if (r < I_O) { transpose_item(w_o, DM, DM, (bf16*)(F.ws + WS_WO), DM, DestId{0}, scr, r, lane_); continue; } r -= I_O;
            if (r < I_G) { transpose_item(w_g, DM, DFF, (bf16*)(F.ws + WS_WGU), DM, DestGU{0}, scr, r, lane_); continue; } r -= I_G;
            if (r < I_G) { transpose_item(w_u, DM, DFF, (bf16*)(F.ws + WS_WGU), DM, DestGU{1}, scr, r, lane_); continue; } r -= I_G;
            transpose_item(w_d, DFF, DM, (bf16*)(F.ws + WS_WDN), DFF, DestId{0}, scr, r, lane_);
        }
    }
    bf16* KB = (bf16*)(F.ws + WS_KB); bf16* VB = (bf16*)(F.ws + WS_VB);
    for (int i = gt; i < 48 * 768; i += NGT) KB[(size_t)(META_ROW0 + 16) * 768 + i] = 0;
    for (int i = gt; i < 48 * 512; i += NGT) VB[(size_t)(META_ROW0 + 16) * 512 + i] = 0;
}

template <typename TA> __device__ __forceinline__ void sg_load_a4(const TA* p, float (&o)[4]);
template <> __device__ __forceinline__ void sg_load_a4<bf16>(const bf16* p, float (&o)[4]) { const u32x2 w = *(const u32x2*)p; o[0] = bf2f(w.x & 0xffffu); o[1] = bf2f(w.x >> 16); o[2] = bf2f(w.y & 0xffffu); o[3] = bf2f(w.y >> 16); }
template <> __device__ __forceinline__ void sg_load_a4<float>(const float* p, float (&o)[4]) { const f32x4 w = *(const f32x4*)p; o[0] = w.x; o[1] = w.y; o[2] = w.z; o[3] = w.w; }

template <bool DUAL, typename TA, class Epi>
__device__ __forceinline__ void sgemm(Frame& F, const TA* A, int lda, int M, const float* W0, const float* W1, int ldw, int N, int K, const Epi& epi) {
    FRAME_IDS;
    float* As = (float*)F.lds;
    float* Bs0 = As + 16 * 132;
    const int tid = tid_, tx = tid & 31, ty = tid >> 5;
    const int NT = DUAL ? 64 : 128;
    const int nMt = (M + 127) / 128, nNt = (N + NT - 1) / NT, items = nMt * nNt;
    for (int item = blockIdx.x; item < items; item += F.G) {
        const int m0 = (item / nNt) * 128, n0 = (item % nNt) * NT;
        float acc0[8][4];
#pragma unroll
        for (int i = 0; i < 8; ++i)
#pragma unroll
            for (int j = 0; j < 4; ++j) acc0[i][j] = 0.f;
        const int ar = tid >> 2, akq = (tid & 3) * 4, bk = tid >> 5, bt = tid & 31;
        const int bcol = DUAL ? n0 + (bt & 15) * 4 : n0 + bt * 4;
        const float* Wb = (DUAL && bt >= 16) ? W1 : W0;
        for (int k0 = 0; k0 < K; k0 += 16) {
            float av[4] = {0.f, 0.f, 0.f, 0.f};
            if (m0 + ar < M) sg_load_a4<TA>(A + (size_t)(m0 + ar) * lda + k0 + akq, av);
            f32x4 b0 = {0.f, 0.f, 0.f, 0.f};
            if (bcol < N) b0 = *(const f32x4*)(Wb + (size_t)(k0 + bk) * ldw + bcol);
            __syncthreads();
#pragma unroll
            for (int i = 0; i < 4; ++i) As[(akq + i) * 132 + ar] = av[i];
            *(f32x4*)(Bs0 + bk * 128 + bt * 4) = b0;
            __syncthreads();
#pragma unroll
            for (int kk = 0; kk < 16; ++kk) {
                const f32x4 a0 = *(const f32x4*)(As + kk * 132 + ty * 8), a1 = *(const f32x4*)(As + kk * 132 + ty * 8 + 4);
                const f32x4 bb0 = *(const f32x4*)(Bs0 + kk * 128 + tx * 4);
                const float a[8] = {a0.x, a0.y, a0.z, a0.w, a1.x, a1.y, a1.z, a1.w};
#pragma unroll
                for (int i = 0; i < 8; ++i) { acc0[i][0] += a[i] * bb0.x; acc0[i][1] += a[i] * bb0.y; acc0[i][2] += a[i] * bb0.z; acc0[i][3] += a[i] * bb0.w; }
            }
        }
        const int ecol = DUAL ? n0 + (tx & 15) * 4 : n0 + tx * 4;
#pragma unroll
        for (int i = 0; i < 8; ++i) {
            float other[4] = {0.f, 0.f, 0.f, 0.f};
            if (DUAL) {
#pragma unroll
                for (int j = 0; j < 4; ++j) other[j] = __shfl_xor(acc0[i][j], 16);
            }
            const int row = m0 + ty * 8 + i;
            if (row < M && ecol < N && (!DUAL || tx < 16)) epi(row, ecol, acc0[i], other);
        }
    }
    __syncthreads();
}
struct EpiStoreF32 { float* C; int ldc;
    __device__ __forceinline__ void operator()(int row, int col, const float (&v)[4], const float (&)[4]) const { *(f32x4*)(C + (size_t)row * ldc + col) = (f32x4){v[0], v[1], v[2], v[3]}; } };
struct EpiX0 { bf16* X0; int g;
    __device__ __forceinline__ void operator()(int row, int col, const float (&v)[4], const float (&)[4]) const {
        const int b = row / LTOK, l = row % LTOK, l1 = l / FN2, l2 = l % FN2;
#pragma unroll
        for (int i = 0; i < 4; ++i) { const int c = col + i, p = c >> 7, d = c & 127, cc = g * 128 + d;
            X0[((((size_t)b * 512 + cc) * FN2 + l2) * 2 + p) * 128 + l1] = (bf16)f2bf(v[i]); }
    } };
struct EpiFold { bf16* WIN; int g;
    __device__ __forceinline__ void operator()(int row, int col, const float (&v)[4], const float (&)[4]) const {
#pragma unroll
        for (int i = 0; i < 4; ++i) WIN[(size_t)(512 + 256 * g + col + i) * DM + row] = (bf16)f2bf(v[i]);
    } };
struct EpiSwiglu { bf16* ACT;
    __device__ __forceinline__ void operator()(int row, int col, const float (&g)[4], const float (&u)[4]) const {
        float o[4];
#pragma unroll
        for (int i = 0; i < 4; ++i) o[i] = g[i] / (1.0f + __expf(-g[i])) * u[i];
        *(u32x2*)(ACT + (size_t)row * DFF + col) = (u32x2){pk2(o[0], o[1]), pk2(o[2], o[3])};
    } };

__device__ __forceinline__ void ph_norms_s(Frame& F) {
    FRAME_IDS;
    const int gw = F.vcu * NWAVES + wave_, NGW = F.G * NWAVES, lane = lane_;
    const float* Z = (const float*)(F.ws + WS_Z); bf16* ZQ = (bf16*)(F.ws + WS_ZQ); bf16* ZKV = (bf16*)(F.ws + WS_ZKV);
    const float2* rope = (const float2*)(F.ws + WS_ROPE);
    for (int r = gw; r < MNAT; r += NGW) {
        const int b = r / LTOK, l = r % LTOK; const float* z = Z + (size_t)r * INW;
        if (l >= NMETA) {
            const int xr = b * SEQ + l - NMETA;
            const f32x4 v = *(const f32x4*)(z + lane * 4);
            const float ss = wave_sum((v.x * v.x + v.y * v.y) + (v.z * v.z + v.w * v.w));
            const float rstd = 1.0f / sqrtf(ss * (1.f / QLR) + EPS);
            const f32x4 g = *(const f32x4*)(F.inp(IN_G_QA) + lane * 4);
            *(u32x2*)(ZQ + (size_t)xr * 256 + lane * 4) = (u32x2){pk2(v.x * rstd * g.x, v.y * rstd * g.y), pk2(v.z * rstd * g.z, v.w * rstd * g.w)};
        }
        const int kvrow = l >= NMETA ? b * SEQ + l - NMETA : (b == 0 ? META_ROW0 + l : -1);
        {
            const float v0 = z[256 + lane * 2], v1 = z[256 + lane * 2 + 1];
            const float ss = wave_sum(v0 * v0 + v1 * v1);
            const float rstd = 1.0f / sqrtf(ss * (1.f / KVLR) + EPS);
            if (kvrow >= 0) {
                bf16* o = ZKV + (size_t)kvrow * 256;
                *(unsigned*)(o + lane * 2) = pk2(v0 * rstd * F.inp(IN_G_KVA)[lane * 2], v1 * rstd * F.inp(IN_G_KVA)[lane * 2 + 1]);
                if (lane < 16) { const float x1 = z[384 + lane], x2 = z[400 + lane]; const float2 cs = rope[l * 16 + lane];
                    o[128 + lane] = (bf16)f2bf(x1 * cs.x - x2 * cs.y); o[144 + lane] = (bf16)f2bf(x2 * cs.x + x1 * cs.y); }
                o[160 + lane] = 0; if (lane < 32) o[224 + lane] = 0;
            }
        }
    }
}
__device__ __forceinline__ void ph_qpost_s(Frame& F) {
    FRAME_IDS;
    const int gw = F.vcu * NWAVES + wave_, NGW = F.G * NWAVES, lane = lane_;
    const float* Y = (const float*)(F.ws + WS_YQ); bf16* Q = (bf16*)(F.ws + WS_Q); const float2* rope = (const float2*)(F.ws + WS_ROPE);
    for (int r = gw; r < MX; r += NGW) {
        const int l = (r % SEQ) + NMETA; const float* y = Y + (size_t)r * 768;
        for (int i = 0; i < 12; ++i) { const int col = lane + 64 * i, d = col % 96; float o;
            if (d < 64) o = y[col];
            else { const int j = d - 64; if (j < 16) { const float2 cs = rope[l * 16 + j]; o = y[col] * cs.x - y[col + 16] * cs.y; }
                   else { const float2 cs = rope[l * 16 + j - 16]; o = y[col] * cs.x + y[col - 16] * cs.y; } }
            Q[(size_t)r * 768 + col] = (bf16)f2bf(o * C2); }
    }
}
__device__ __forceinline__ void ph_kvpost_s(Frame& F) {
    FRAME_IDS;
    const int gw = F.vcu * NWAVES + wave_, NGW = F.G * NWAVES, lane = lane_;
    const float* Y = (const float*)(F.ws + WS_YQ); bf16* KB = (bf16*)(F.ws + WS_KB); bf16* VB = (bf16*)(F.ws + WS_VB); const bf16* ZKV = (const bf16*)(F.ws + WS_ZKV);
    for (int r = gw; r < META_ROW0 + NMETA; r += NGW) {
        const float* y = Y + (size_t)r * 1024;
        for (int i = 0; i < 16; ++i) { const int col = lane + 64 * i, h = col >> 7, d = col & 127;
            if (d < 64) KB[(size_t)r * 768 + h * 96 + d] = (bf16)f2bf(y[col]); else VB[(size_t)r * 512 + h * 64 + d - 64] = (bf16)f2bf(y[col]); }
        for (int i = 0; i < 4; ++i) { const int idx = lane + 64 * i, h = idx >> 5, j = idx & 31; KB[(size_t)r * 768 + h * 96 + 64 + j] = ZKV[(size_t)r * 256 + 128 + j]; }
    }
}
__device__ __forceinline__ void ph_s1_s(Frame& F) {
    FRAME_IDS;
    const int gw = F.vcu * NWAVES + wave_, NGW = F.G * NWAVES, lane = lane_;
    float* tab = (float*)F.lds;
    float* us = (float*)F.lds + 256 + wave_ * 256;
    for (int i = tid_; i < FN1; i += NTHR) { const float fr = (float)i / (float)FN1; tab[i] = hw_cos(fr); tab[128 + i] = hw_sin(fr); }
    __syncthreads();
    const bf16* X0 = (const bf16*)(F.ws + WS_X0); bf16* X1 = (bf16*)(F.ws + WS_X1); const float2* tw = (const float2*)(F.ws + WS_TW);
    for (int it = gw; it < NB * 512 * FN2; it += NGW) {
        const int l2 = it % FN2, cc = (it / FN2) % 512, b = it / (FN2 * 512);
        const bf16* src = X0 + (size_t)it * 256;
        { const u32x2 w = *(const u32x2*)(src + lane * 4); us[lane * 4] = bf2f(w.x & 0xffffu); us[lane * 4 + 1] = bf2f(w.x >> 16); us[lane * 4 + 2] = bf2f(w.y & 0xffffu); us[lane * 4 + 3] = bf2f(w.y >> 16); }
        __builtin_amdgcn_wave_barrier(); asm volatile("s_waitcnt lgkmcnt(0)" ::: "memory");
        for (int k1 = lane; k1 < FN1; k1 += 64) {
            float ar = 0.f, ai = 0.f; int m = 0;
            for (int l1 = 0; l1 < FN1; ++l1) { const float c = tab[m], s = tab[128 + m], ur = us[l1], ui = us[128 + l1];
                ar += ur * c + ui * s; ai += ui * c - ur * s; m += k1; if (m >= FN1) m -= FN1; }
            const float2 t = tw[l2 * k1];
            const float br = ar * t.x + ai * t.y, bi = ai * t.x - ar * t.y;
            bf16* dst = X1 + ((((size_t)b * FN1 + k1) * 512 + cc) * 2) * 128 + l2;
            dst[0] = (bf16)f2bf(br); dst[128] = (bf16)f2bf(bi);
        }
        __builtin_amdgcn_wave_barrier(); asm volatile("s_waitcnt lgkmcnt(0)" ::: "memory");
    }
    __syncthreads();
}
__device__ __forceinline__ void ph_s2_s(Frame& F) {
    FRAME_IDS;
    const int gw = F.vcu * NWAVES + wave_, NGW = F.G * NWAVES, lane = lane_;
    float* tab = (float*)F.lds; float* us = (float*)F.lds + 256 + wave_ * 256;
    for (int i = tid_; i < FN2; i += NTHR) { const float fr = (float)i / (float)FN2; tab[i] = hw_cos(fr); tab[128 + i] = hw_sin(fr); }
    __syncthreads();
    const bf16* X1 = (const bf16*)(F.ws + WS_X1); bf16* AO = (bf16*)(F.ws + WS_AO);
    for (int it = gw; it < NB * FN1 * 512; it += NGW) {
        const int cc = it % 512, k1 = (it / 512) % FN1, b = it / (512 * FN1);
        const bf16* src = X1 + (size_t)it * 256;
        { const u32x2 w = *(const u32x2*)(src + lane * 4); us[lane * 4] = bf2f(w.x & 0xffffu); us[lane * 4 + 1] = bf2f(w.x >> 16); us[lane * 4 + 2] = bf2f(w.y & 0xffffu); us[lane * 4 + 3] = bf2f(w.y >> 16); }
        __builtin_amdgcn_wave_barrier(); asm volatile("s_waitcnt lgkmcnt(0)" ::: "memory");
        const float bias = F.inp(IN_B_FOUR)[cc];
        for (int k2 = lane; k2 < FN2; k2 += 64) {
            float y = 0.f; int m = 0;
            for (int l2 = 0; l2 < FN2; ++l2) { y += us[l2] * tab[m] + us[128 + l2] * tab[128 + m]; m += k2; if (m >= FN2) m -= FN2; }
            const int k = k1 + FN1 * k2;
            if (k >= NMETA) AO[((size_t)b * SEQ + k - NMETA) * 1024 + 512 + cc] = (bf16)f2bf(y + bias);
        }
        __builtin_amdgcn_wave_barrier(); asm volatile("s_waitcnt lgkmcnt(0)" ::: "memory");
    }
    __syncthreads();
}
__device__ __forceinline__ void ph_attn_s(Frame& F) {
    FRAME_IDS;
    float* Ks = (float*)F.lds;
    float* Vs = Ks + 64 * 96;
    const bf16* Q = (const bf16*)(F.ws + WS_Q); const bf16* KB = (const bf16*)(F.ws + WS_KB); const bf16* VB = (const bf16*)(F.ws + WS_VB); bf16* AO = (bf16*)(F.ws + WS_AO);
    const int tid = tid_, hf = tid & 1;
    for (int item = blockIdx.x; item < NB * NH * 32; item += F.G) {
        const int b = item >> 8, h = (item >> 5) & 7, qb = item & 31;
        const int xr = b * SEQ + qb * 256 + (tid >> 1);
        float q[48], o[32];
#pragma unroll
        for (int c = 0; c < 6; ++c) { const u32x4 w = *(const u32x4*)(Q + (size_t)xr * 768 + h * 96 + hf * 48 + c * 8);
            q[c * 8 + 0] = bf2f(w.x & 0xffffu); q[c * 8 + 1] = bf2f(w.x >> 16); q[c * 8 + 2] = bf2f(w.y & 0xffffu); q[c * 8 + 3] = bf2f(w.y >> 16);
            q[c * 8 + 4] = bf2f(w.z & 0xffffu); q[c * 8 + 5] = bf2f(w.z >> 16); q[c * 8 + 6] = bf2f(w.w & 0xffffu); q[c * 8 + 7] = bf2f(w.w >> 16); }
#pragma unroll
        for (int d = 0; d < 32; ++d) o[d] = 0.f;
        float m = -1e30f, l = 0.f;
        for (int tile = 0; tile < 129; ++tile) {
            const int nkeys = tile < 128 ? 64 : 16; const int krow0 = tile < 128 ? b * SEQ + tile * 64 : META_ROW0;
            __syncthreads();
            for (int c = tid; c < 768; c += NTHR) { const int row = c / 12, part = c % 12;
                if (row < nkeys) { const u32x4 w = *(const u32x4*)(KB + (size_t)(krow0 + row) * 768 + h * 96 + part * 8); float* dst = Ks + row * 96 + part * 8;
                    dst[0] = bf2f(w.x & 0xffffu); dst[1] = bf2f(w.x >> 16); dst[2] = bf2f(w.y & 0xffffu); dst[3] = bf2f(w.y >> 16);
                    dst[4] = bf2f(w.z & 0xffffu); dst[5] = bf2f(w.z >> 16); dst[6] = bf2f(w.w & 0xffffu); dst[7] = bf2f(w.w >> 16); } }
            { const int row = tid >> 3, part = tid & 7;
                if (row < nkeys) { const u32x4 w = *(const u32x4*)(VB + (size_t)(krow0 + row) * 512 + h * 64 + part * 8); float* dst = Vs + row * 64 + part * 8;
                    dst[0] = bf2f(w.x & 0xffffu); dst[1] = bf2f(w.x >> 16); dst[2] = bf2f(w.y & 0xffffu); dst[3] = bf2f(w.y >> 16);
                    dst[4] = bf2f(w.z & 0xffffu); dst[5] = bf2f(w.z >> 16); dst[6] = bf2f(w.w & 0xffffu); dst[7] = bf2f(w.w >> 16); } }
            __syncthreads();
            for (int j0 = 0; j0 < nkeys; j0 += 8) {
                float s[8];
#pragma unroll
                for (int jj = 0; jj < 8; ++jj) { const float* kr = Ks + (j0 + jj) * 96 + hf * 48; float a = 0.f;
#pragma unroll
                    for (int d = 0; d < 48; ++d) a += q[d] * kr[d];
                    s[jj] = a + __shfl_xor(a, 1); }
                float cm = s[0];
#pragma unroll
                for (int jj = 1; jj < 8; ++jj) cm = fmaxf(cm, s[jj]);
                const float mn = fmaxf(m, cm), alpha = exp2f(m - mn); m = mn; l *= alpha;
#pragma unroll
                for (int d = 0; d < 32; ++d) o[d] *= alpha;
#pragma unroll
                for (int jj = 0; jj < 8; ++jj) { const float p = exp2f(s[jj] - m); l += p; const float* vr = Vs + (j0 + jj) * 64 + hf * 32;
#pragma unroll
                    for (int d = 0; d < 32; ++d) o[d] += p * vr[d]; }
            }
        }
        const float rl = 1.0f / l;
#pragma unroll
        for (int c = 0; c < 4; ++c) { u32x4 w; w.x = pk2(o[c * 8] * rl, o[c * 8 + 1] * rl); w.y = pk2(o[c * 8 + 2] * rl, o[c * 8 + 3] * rl); w.z = pk2(o[c * 8 + 4] * rl, o[c * 8 + 5] * rl); w.w = pk2(o[c * 8 + 6] * rl, o[c * 8 + 7] * rl);
            *(u32x4*)(AO + (size_t)xr * 1024 + h * 64 + hf * 32 + c * 8) = w; }
    }
    __syncthreads();
}
__device__ __forceinline__ void ph_mrg_s(Frame& F) {
    FRAME_IDS;
    const int gw = F.vcu * NWAVES + wave_, NGW = F.G * NWAVES, lane = lane_;
    const bf16* AO = (const bf16*)(F.ws + WS_AO); bf16* MRG = (bf16*)(F.ws + WS_MRG);
    for (int r = gw; r < MX; r += NGW) {
#pragma unroll
        for (int half = 0; half < 2; ++half) {
            const u32x4 w = *(const u32x4*)(AO + (size_t)r * 1024 + half * 512 + lane * 8);
            float v[8] = {bf2f(w.x & 0xffffu), bf2f(w.x >> 16), bf2f(w.y & 0xffffu), bf2f(w.y >> 16), bf2f(w.z & 0xffffu), bf2f(w.z >> 16), bf2f(w.w & 0xffffu), bf2f(w.w >> 16)};
            float ss = 0.f;
#pragma unroll
            for (int i = 0; i < 8; ++i) ss += v[i] * v[i];
            const float rstd = 1.0f / sqrtf(wave_sum(ss) * (1.f / 512.f) + EPS);
            const float* g = (half ? F.inp(IN_G_FOUR) : F.inp(IN_G_ATTN)) + lane * 8;
            u32x4 o; o.x = pk2(v[0] * rstd * g[0], v[1] * rstd * g[1]); o.y = pk2(v[2] * rstd * g[2], v[3] * rstd * g[3]); o.z = pk2(v[4] * rstd * g[4], v[5] * rstd * g[5]); o.w = pk2(v[6] * rstd * g[6], v[7] * rstd * g[7]);
            *(u32x4*)(MRG + (size_t)r * 1024 + half * 512 + lane * 8) = o;
        }
    }
}
__device__ __forceinline__ void ph_wopost_s(Frame& F) {
    FRAME_IDS;
    const int gw = F.vcu * NWAVES + wave_, NGW = F.G * NWAVES, lane = lane_;
    const float* Y = (const float*)(F.ws + WS_Y3); bf16* XN2 = (bf16*)(F.ws + WS_XN);
    for (int r = gw; r < MX; r += NGW) {
        const f32x4* yr = (const f32x4*)(Y + (size_t)r * DM) + lane; const f32x4* xr = (const f32x4*)(F.inp(IN_X) + (size_t)r * DM) + lane;
        f32x4 v[4]; float s = 0.f;
#pragma unroll
        for (int j = 0; j < 4; ++j) { v[j] = yr[64 * j]; s += (v[j].x * v[j].x + v[j].y * v[j].y) + (v[j].z * v[j].z + v[j].w * v[j].w); }
        const float rstd = 1.0f / sqrtf(wave_sum(s) * (1.f / DM) + EPS);
        float s2 = 0.f;
#pragma unroll
        for (int j = 0; j < 4; ++j) { const f32x4 g = ((const f32x4*)F.inp(IN_G_POST))[lane + 64 * j]; v[j] = xr[64 * j] + v[j] * rstd * g;
            s2 += (v[j].x * v[j].x + v[j].y * v[j].y) + (v[j].z * v[j].z + v[j].w * v[j].w); ((f32x4*)(F.out + (size_t)r * DM))[lane + 64 * j] = v[j]; }
        const float rstd2 = 1.0f / sqrtf(wave_sum(s2) * (1.f / DM) + EPS);
        unsigned long long* o8 = (unsigned long long*)(XN2 + (size_t)r * DM) + lane;
#pragma unroll
        for (int j = 0; j < 4; ++j) { const f32x4 g = ((const f32x4*)F.inp(IN_G_PREFFN))[lane + 64 * j];
            o8[64 * j] = (unsigned long long)pk2(v[j].x * rstd2 * g.x, v[j].y * rstd2 * g.y) | ((unsigned long long)pk2(v[j].z * rstd2 * g.z, v[j].w * rstd2 * g.w) << 32); }
    }
}
__device__ __forceinline__ void ph_dnpost_s(Frame& F) {
    FRAME_IDS;
    const int gw = F.vcu * NWAVES + wave_, NGW = F.G * NWAVES, lane = lane_;
    const float* Y = (const float*)(F.ws + WS_Y5);
    for (int r = gw; r < MX; r += NGW) {
        const f32x4* yr = (const f32x4*)(Y + (size_t)r * DM) + lane; f32x4* orow = (f32x4*)(F.out + (size_t)r * DM) + lane;
        f32x4 v[4]; float s = 0.f;
#pragma unroll
        for (int j = 0; j < 4; ++j) { v[j] = yr[64 * j]; s += (v[j].x * v[j].x + v[j].y * v[j].y) + (v[j].z * v[j].z + v[j].w * v[j].w); }
        const float rstd = 1.0f / sqrtf(wave_sum(s) * (1.f / DM) + EPS);
#pragma unroll
        for (int j = 0; j < 4; ++j) { const f32x4 g = ((const f32x4*)F.inp(IN_G_POSTFFN))[lane + 64 * j]; orow[64 * j] = orow[64 * j] + v[j] * rstd * g; }
    }
}

enum Phase { PH_PRO = 0, PH_PRO2, PH_INPROJ, PH_QKV, PH_ATTN, PH_MRG_S, PH_WO, PH_WOPOST_S, PH_GU, PH_DN, PH_DNPOST_S, PH_COUNT };

struct Args { const float* in[19]; float* out; unsigned char* ws; int ph_lo, ph_hi, use_bar, pad; };

__global__ void __launch_bounds__(NTHR, 2) mega_fwd(Args args) {
    extern __shared__ __attribute__((aligned(16))) unsigned char lds[];
    Frame F;
    F.lds = lds;
    F.G = gridDim.x; { const int bx = blockIdx.x; F.vcu = (F.G % 8 == 0) ? (bx % 8) * (F.G / 8) + bx / 8 : bx; }
    F.out = args.out; F.ws = args.ws;
    volatile LAS unsigned* MISC = (volatile LAS unsigned*)((LAS unsigned char*)lds + MISC_OFF);
    for (int u = (int)threadIdx.x; u < (LDS_BYTES - LDSCTL_OFF) / 4; u += NTHR) ((LAS unsigned*)((LAS unsigned char*)lds + LDSCTL_OFF))[u] = 0u;
    if ((int)threadIdx.x < 19) { const unsigned long long p = (unsigned long long)args.in[(int)threadIdx.x]; LAS unsigned* t = (LAS unsigned*)((LAS unsigned char*)lds + PTR_OFF) + 2 * (int)threadIdx.x; t[0] = (unsigned)p; t[1] = (unsigned)(p >> 32); }
    __syncthreads();
    XcdBarrier bar; bar.bar = (unsigned*)(F.ws + WS_CTL) + CW_BAR; bar.x = 0; bar.st = nullptr;
    if (args.use_bar) bar = xcd_barrier_post((unsigned*)(F.ws + WS_CTL) + CW_BAR, MISC + 8);

    const int lo = args.ph_lo, hi = args.ph_hi;
    LAS unsigned char* ldsl = (LAS unsigned char*)lds;
#define PHASE(k, ...) do { if (lo <= (k) && (k) < hi) { __VA_ARGS__; if ((k) + 1 < hi) xcd_barrier(bar); } } while (0)
    PHASE(PH_PRO, ph_prologue(F));
    PHASE(PH_PRO2, { for (int g = 0; g < 4; ++g) sgemm<false, float>(F, F.inp(IN_W_IN) + 416 + g * 128, INW, DM, (const float*)(F.ws + WS_WU) + (size_t)g * 128 * 256, nullptr, 256, 256, 128, EpiFold{(bf16*)(F.ws + WS_WIN), g}); });
    PHASE(PH_INPROJ, { pg8::SchedInNat S{F.vcu, (const char*)(F.ws + WS_XN), (const char*)(F.ws + WS_WIN)};
        pg8::gemm_phase(ldsl, pg8::Gemm{DM, (size_t)128 * DM * 2, (size_t)128 * DM * 2, DM * 2, 127}, S,
            pg8::EpiInNat{(bf16*)(F.ws + WS_ZQ), (bf16*)(F.ws + WS_ZKV), F.inp(IN_G_QA), F.inp(IN_G_KVA), (const float2*)(F.ws + WS_ROPE), (LAS float*)(ldsl + LDSCTL_OFF + 2048)});
        pg8::SchedInG S2{F.vcu, (const char*)(F.ws + WS_XN), (const char*)(F.ws + WS_WIN)};
        pg8::gemm_phase(ldsl, pg8::Gemm{DM, (size_t)DM * 2, (size_t)128 * DM * 2, FN2 * DM * 2, FN1 - 1}, S2, pg8::EpiInG{(bf16*)(F.ws + WS_X0)}); });
    PHASE(PH_QKV, { pg8::StaticOrder S; S.init(F.ws + WS_ZQ, F.ws + WS_WQB, MX, 768, 256, F.G, (int)blockIdx.x);
        pg8::gemm_phase(ldsl, pg8::Gemm{256, (size_t)128 * 256 * 2, (size_t)128 * 256 * 2, 256 * 2, 127}, S, pg8::EpiQ{(bf16*)(F.ws + WS_Q), (const float2*)(F.ws + WS_ROPE)});
        pg8::StaticOrder S2; S2.init(F.ws + WS_ZKV, F.ws + WS_WKV, KVROWS, 1280, 256, F.G, (int)((blockIdx.x + 128) % F.G));
        pg8::gemm_phase(ldsl, pg8::Gemm{256, (size_t)128 * 256 * 2, (size_t)128 * 256 * 2, 256 * 2, 127}, S2, pg8::EpiKV{(bf16*)(F.ws + WS_KB), (bf16*)(F.ws + WS_VB)});
        pg8::StaticOrder S3; S3.init(F.ws + WS_X0, F.ws + WS_DD1, NB * 512 * FN2, 256, 256, F.G, (int)((blockIdx.x + 192) % F.G));
        pg8::gemm_phase(ldsl, pg8::Gemm{256, (size_t)128 * 256 * 2, (size_t)128 * 256 * 2, 256 * 2, 127}, S3, pg8::EpiS1{(bf16*)(F.ws + WS_X1), (const float2*)(F.ws + WS_TW)}); });
    PHASE(PH_ATTN, { ph_attn_f(F);
        pg8::StaticOrder S4; S4.init(F.ws + WS_X1, F.ws + WS_D2, NB * FN1 * 512, 256, 256, F.G, (int)blockIdx.x);
        pg8::gemm_phase(ldsl, pg8::Gemm{256, (size_t)128 * 256 * 2, (size_t)128 * 256 * 2, 256 * 2, 127}, S4, pg8::EpiS2{(bf16*)(F.ws + WS_AO), F.inp(IN_B_FOUR)}); });
    PHASE(PH_MRG_S, ph_mrg_s(F));
    PHASE(PH_WO, { pg8::StaticOrder S; S.init(F.ws + WS_MRG, F.ws + WS_WO, MX, DM, DM, F.G, (int)blockIdx.x);
        pg8::gemm_phase(ldsl, pg8::Gemm{DM, (size_t)128 * DM * 2, (size_t)128 * DM * 2, DM * 2, 127}, S, pg8::EpiF32{(float*)(F.ws + WS_Y3), DM}); });
    PHASE(PH_WOPOST_S, ph_wopost_s(F));
    PHASE(PH_GU, { pg8::StaticOrder S; S.init(F.ws + WS_XN, F.ws + WS_WGU, MX, 2 * DFF, DM, F.G, (int)blockIdx.x);
        pg8::gemm_phase(ldsl, pg8::Gemm{DM, (size_t)128 * DM * 2, (size_t)128 * DM * 2, DM * 2, 127}, S, pg8::EpiSwigluF{(bf16*)(F.ws + WS_ACT), DFF}); });
    PHASE(PH_DN, { pg8::StaticOrder S; S.init(F.ws + WS_ACT, F.ws + WS_WDN, MX, DM, DFF, F.G, (int)blockIdx.x);
        pg8::gemm_phase(ldsl, pg8::Gemm{DFF, (size_t)128 * DFF * 2, (size_t)128 * DFF * 2, DFF * 2, 127}, S, pg8::EpiF32{(float*)(F.ws + WS_Y5), DM}); });
    PHASE(PH_DNPOST_S, ph_dnpost_s(F));
#undef PHASE
}

#ifndef MK_ONE_LAUNCH
#define MK_ONE_LAUNCH 1
#endif
extern "C" void kernel_launch(void* const* d_in, const int* in_sizes, int n_in, void* d_out, int out_size, void* d_ws, size_t ws_size, hipStream_t stream) {
    static int grid = 0;
    if (grid == 0) {
        if (n_in != 19 || out_size != MX * DM || ws_size < WS_END) { fprintf(stderr, "kernel_launch: unexpected shapes n_in %d out %d ws %zu\n", n_in, out_size, ws_size); grid = -1; return; }
        int dev = 0, cus = 0, per_cu = 0;
        hipGetDevice(&dev); hipDeviceGetAttribute(&cus, hipDeviceAttributeMultiprocessorCount, dev);
        if (hipFuncSetAttribute((const void*)mega_fwd, hipFuncAttributeMaxDynamicSharedMemorySize, LDS_BYTES) != hipSuccess) { fprintf(stderr, "kernel_launch: hipFuncSetAttribute failed\n"); grid = -1; return; }
        if (hipOccupancyMaxActiveBlocksPerMultiprocessor(&per_cu, (const void*)mega_fwd, NTHR, LDS_BYTES) != hipSuccess || per_cu < 1) { fprintf(stderr, "kernel_launch: occupancy query gives %d\n", per_cu); per_cu = 1; }
        (void)hipGetLastError();
        grid = cus * 1;
        if (grid != 256) { fprintf(stderr, "kernel_launch: this kernel is written for a 256-CU device (got %d)\n", cus); grid = -1; return; }
        fprintf(stderr, "kernel_launch: cus %d per_cu %d grid %d ws %zu\n", cus, per_cu, grid, ws_size);
    }
    if (grid < 0) return;
    hipMemsetAsync((char*)d_ws + WS_CTL, 0, CTL_ZERO_BYTES, stream);
    Args a{};
    for (int i = 0; i < 19; ++i) a.in[i] = (const float*)d_in[i];
    a.out = (float*)d_out; a.ws = (unsigned char*)d_ws;
#if MK_ONE_LAUNCH
    a.ph_lo = 0; a.ph_hi = PH_COUNT; a.use_bar = 1;
    void* kargs[] = {&a};
    hipError_t e = hipLaunchCooperativeKernel((const void*)mega_fwd, dim3(grid), dim3(NTHR), kargs, LDS_BYTES, stream);
    if (e != hipSuccess) fprintf(stderr, "kernel_launch: cooperative launch failed: %s\n", hipGetErrorString(e));
#else
    for (int ph = 0; ph < PH_COUNT; ++ph) {
        a.ph_lo = ph; a.ph_hi = ph + 1; a.use_bar = 0;
        hipLaunchKernelGGL(mega_fwd, dim3(grid), dim3(NTHR), LDS_BYTES, stream, a);
    }
#endif
}
```
